# Optimizing an MI355X kernel written in HIP

```python
import math
import jax, jax.numpy as jnp
from jax import lax
import numpy as np

D_MODEL = 1024
BATCH = 8
SEQ = 2048
DEPTH = 1

HEAD_DIM = 64
N_DIFF_HEADS = 4
DIFF_V_DIM = 2 * HEAD_DIM
N_FOX_HEADS = 8
DIFF_WIDTH = N_DIFF_HEADS * DIFF_V_DIM
FOX_WIDTH = N_FOX_HEADS * HEAD_DIM
MIX_WIDTH = DIFF_WIDTH + FOX_WIDTH
ROT_DIM = HEAD_DIM // 4
ROPE_THETA = 500000.0
Q_BLOCK = 128
DQ_W = N_DIFF_HEADS * 2 * HEAD_DIM
DK_W = N_DIFF_HEADS * 2 * HEAD_DIM
DV_W = DIFF_WIDTH
FQ_W = FOX_WIDTH
FK_W = FOX_WIDTH
FV_W = FOX_WIDTH
FF_W = N_FOX_HEADS
IN_WIDTH = DQ_W + DK_W + DV_W + FQ_W + FK_W + FV_W + FF_W
IN_SPLITS = [DQ_W, DQ_W + DK_W, DQ_W + DK_W + DV_W, DQ_W + DK_W + DV_W + FQ_W,
             DQ_W + DK_W + DV_W + FQ_W + FK_W, DQ_W + DK_W + DV_W + FQ_W + FK_W + FV_W]
N_EXPERTS = 32
TOP_K = 4
D_EXPERT = D_MODEL
SWIGLU_ALPHA = 1.702
SWIGLU_LIMIT = 7.0
MOE_BLOCK = 128
PLE_DIM = 256
NORM_EPS = 1e-5

kernel_name = "hymba_style_diff_fox_moe_block"


def rms_norm(x, g):
    xf = x.astype(jnp.float32)
    y = xf * lax.rsqrt(jnp.mean(xf * xf, axis=-1, keepdims=True) + NORM_EPS)
    return (y * g.astype(jnp.float32)).astype(x.dtype)


def partial_rope(x, positions):
    inv_freq = ROPE_THETA ** (-jnp.arange(0, ROT_DIM, 2, dtype=jnp.float32) / ROT_DIM)
    ang = positions.astype(jnp.float32)[:, :, None] * inv_freq
    ang = ang.reshape(ang.shape[:2] + (1,) * (x.ndim - 3) + (ROT_DIM // 2,))
    cos, sin = jnp.cos(ang), jnp.sin(ang)
    xf = x.astype(jnp.float32)
    x1 = xf[..., :ROT_DIM // 2]
    x2 = xf[..., ROT_DIM // 2:ROT_DIM]
    out = jnp.concatenate([x1 * cos - x2 * sin, x2 * cos + x1 * sin, xf[..., ROT_DIM:]], axis=-1)
    return out.astype(x.dtype)


def diff_attention(q, k, v, lam):
    b, s, h, _, dh = q.shape
    nb = s // Q_BLOCK
    q = q.transpose(0, 2, 3, 1, 4)
    k = k.transpose(0, 2, 3, 1, 4)
    v = v.transpose(0, 2, 1, 3)
    qb = jnp.moveaxis(q.reshape(b, h, 2, nb, Q_BLOCK, dh), 3, 0)
    scale = dh ** -0.5
    k_pos = jnp.arange(s)

    def block(args):
        q_blk, qi = args
        sc = jnp.einsum('bhmqd,bhmkd->bhmqk', q_blk, k).astype(jnp.float32) * scale
        mask = k_pos[None, :] <= (qi * Q_BLOCK + jnp.arange(Q_BLOCK))[:, None]
        a = jax.nn.softmax(jnp.where(mask, sc, -jnp.inf), axis=-1)
        a = a[:, :, 0] - lam * a[:, :, 1]
        return jnp.einsum('bhqk,bhkd->bhqd', a.astype(v.dtype), v)

    o = lax.map(block, (qb, jnp.arange(nb)))
    return jnp.moveaxis(o, 0, 2).reshape(b, h, s, -1).transpose(0, 2, 1, 3)


def forgetting_attention(q, k, v, c):
    b, s, h, dh = q.shape
    nb = s // Q_BLOCK
    q = q.transpose(0, 2, 1, 3)
    k = k.transpose(0, 2, 1, 3)
    v = v.transpose(0, 2, 1, 3)
    c = c.transpose(0, 2, 1)
    qb = jnp.moveaxis(q.reshape(b, h, nb, Q_BLOCK, dh), 2, 0)
    cb = jnp.moveaxis(c.reshape(b, h, nb, Q_BLOCK), 2, 0)
    scale = dh ** -0.5
    k_pos = jnp.arange(s)

    def block(args):
        q_blk, c_blk, qi = args
        sc = jnp.einsum('bhqd,bhkd->bhqk', q_blk, k).astype(jnp.float32) * scale
        sc = sc + c_blk[..., :, None] - c[..., None, :]
        mask = k_pos[None, :] <= (qi * Q_BLOCK + jnp.arange(Q_BLOCK))[:, None]
        a = jax.nn.softmax(jnp.where(mask, sc, -jnp.inf), axis=-1)
        return jnp.einsum('bhqk,bhkd->bhqd', a.astype(v.dtype), v)

    o = lax.map(block, (qb, cb, jnp.arange(nb)))
    return jnp.moveaxis(o, 0, 2).reshape(b, h, s, dh).transpose(0, 2, 1, 3)


def hybrid_mixer(xn, positions, w_in, lq1, lk1, lq2, lk2, g_subln, b_forget, w_out, lambda_init):
    b, s, _ = xn.shape
    proj = xn @ w_in
    dq, dk, dv, fq, fk, fv, fz = jnp.split(proj, IN_SPLITS, axis=-1)
    dq = partial_rope(dq.reshape(b, s, N_DIFF_HEADS, 2, HEAD_DIM), positions)
    dk = partial_rope(dk.reshape(b, s, N_DIFF_HEADS, 2, HEAD_DIM), positions)
    dv = dv.reshape(b, s, N_DIFF_HEADS, DIFF_V_DIM)
    f32 = jnp.float32
    lam = (jnp.exp(jnp.sum(lq1.astype(f32) * lk1.astype(f32)))
           - jnp.exp(jnp.sum(lq2.astype(f32) * lk2.astype(f32))) + lambda_init)
    d_out = diff_attention(dq, dk, dv, lam)
    d_out = rms_norm(d_out, g_subln) * (1.0 - lambda_init)
    logf = jax.nn.log_sigmoid(fz.astype(f32) + b_forget.astype(f32))
    c = jnp.cumsum(logf, axis=1)
    f_out = forgetting_attention(fq.reshape(b, s, N_FOX_HEADS, HEAD_DIM),
                                 fk.reshape(b, s, N_FOX_HEADS, HEAD_DIM),
                                 fv.reshape(b, s, N_FOX_HEADS, HEAD_DIM), c)
    mixed = jnp.concatenate([d_out.reshape(b, s, DIFF_WIDTH), f_out.reshape(b, s, FOX_WIDTH)], axis=-1)
    return mixed @ w_out


def moe(xn, w_router, b_router, w1, b1, w2, b2):
    b, s, d = xn.shape
    n = b * s
    xf = xn.reshape(n, d)
    logits = xf.astype(jnp.float32) @ w_router.astype(jnp.float32) + b_router.astype(jnp.float32)
    top_vals, top_idx = lax.top_k(logits, TOP_K)
    gates = jax.nn.softmax(top_vals, axis=-1)
    a = n * TOP_K
    flat_e = top_idx.reshape(a).astype(jnp.int32)
    flat_tok = jnp.arange(a, dtype=jnp.int32) // TOP_K
    flat_w = gates.reshape(a)
    counts = jnp.zeros((N_EXPERTS,), jnp.int32).at[flat_e].add(1)
    padded_counts = (counts + MOE_BLOCK - 1) // MOE_BLOCK * MOE_BLOCK
    padded_ends = jnp.cumsum(padded_counts)
    padded_starts = padded_ends - padded_counts
    starts = jnp.cumsum(counts) - counts
    order = jnp.argsort(flat_e)
    sorted_e = flat_e[order]
    dest = padded_starts[sorted_e] + (jnp.arange(a, dtype=jnp.int32) - starts[sorted_e])
    n_rows = a + N_EXPERTS * MOE_BLOCK
    n_blocks = n_rows // MOE_BLOCK
    row_tok = jnp.zeros((n_rows,), jnp.int32).at[dest].set(flat_tok[order])
    row_w = jnp.zeros((n_rows,), jnp.float32).at[dest].set(flat_w[order])
    block_e = jnp.clip(jnp.searchsorted(padded_ends, jnp.arange(n_blocks) * MOE_BLOCK, side='right'),
                       0, N_EXPERTS - 1).astype(jnp.int32)
    x_rows = xf[row_tok].reshape(n_blocks, MOE_BLOCK, d)

    def expert_block(args):
        xb, e = args
        h = xb @ w1[e] + b1[e]
        glu = jnp.minimum(h[..., ::2], SWIGLU_LIMIT)
        lin = jnp.clip(h[..., 1::2], -SWIGLU_LIMIT, SWIGLU_LIMIT)
        act = glu * jax.nn.sigmoid(SWIGLU_ALPHA * glu) * (lin + 1.0)
        return act @ w2[e] + b2[e]

    y = lax.map(expert_block, (x_rows, block_e)).reshape(n_rows, d)
    out = jnp.zeros((n, d), y.dtype).at[row_tok].add(y * row_w.astype(y.dtype)[:, None])
    return out.reshape(b, s, d)


def setup_inputs(seed: int = 0) -> dict:
    key = jax.random.key(seed)
    ks = jax.random.split(key, 24)
    nrm = jax.random.normal
    L, D, E, I = DEPTH, D_MODEL, N_EXPERTS, D_EXPERT
    return {
        "x": nrm(ks[0], (BATCH, SEQ, D), jnp.float32),
        "p": nrm(ks[1], (L, BATCH, SEQ, PLE_DIM), jnp.float32),
        "positions": (jnp.arange(SEQ, dtype=jnp.int32)[None, :]
                      + jax.random.randint(ks[2], (BATCH, 1), 0, 4096, dtype=jnp.int32)),
        "g_attn": 1.0 + 0.02 * nrm(ks[3], (L, D), jnp.float32),
        "w_in": nrm(ks[4], (L, D, IN_WIDTH), jnp.float32) * D ** -0.5,
        "lambda_q1": 0.1 * nrm(ks[5], (L, HEAD_DIM), jnp.float32),
        "lambda_k1": 0.1 * nrm(ks[6], (L, HEAD_DIM), jnp.float32),
        "lambda_q2": 0.1 * nrm(ks[7], (L, HEAD_DIM), jnp.float32),
        "lambda_k2": 0.1 * nrm(ks[8], (L, HEAD_DIM), jnp.float32),
        "g_subln": 1.0 + 0.02 * nrm(ks[9], (L, DIFF_V_DIM), jnp.float32),
        "b_forget": 2.0 + 0.5 * nrm(ks[10], (L, N_FOX_HEADS), jnp.float32),
        "w_out": nrm(ks[11], (L, MIX_WIDTH, D), jnp.float32) * MIX_WIDTH ** -0.5,
        "g_moe": 1.0 + 0.02 * nrm(ks[12], (L, D), jnp.float32),
        "w_router": nrm(ks[13], (L, D, E), jnp.float32) * D ** -0.5,
        "b_router": 0.01 * nrm(ks[14], (L, E), jnp.float32),
        "w_e1": nrm(ks[15], (L, E, D, 2 * I), jnp.float32) * D ** -0.5,
        "b_e1": 0.01 * nrm(ks[16], (L, E, 2 * I), jnp.float32),
        "w_e2": nrm(ks[17], (L, E, I, D), jnp.float32) * I ** -0.5,
        "b_e2": 0.01 * nrm(ks[18], (L, E, D), jnp.float32),
        "g_ple": 1.0 + 0.02 * nrm(ks[19], (L, D), jnp.float32),
        "w_ple_gate": nrm(ks[20], (L, D, D), jnp.float32) * D ** -0.5,
        "w_ple_proj": nrm(ks[21], (L, PLE_DIM, D), jnp.float32) * PLE_DIM ** -0.5,
        "g_final": 1.0 + 0.02 * nrm(ks[22], (D,), jnp.float32),
    }


def reference(x, p, positions, g_attn, w_in, lambda_q1, lambda_k1, lambda_q2, lambda_k2,
              g_subln, b_forget, w_out, g_moe, w_router, b_router, w_e1, b_e1, w_e2, b_e2,
              g_ple, w_ple_gate, w_ple_proj, g_final):
    h = x
    for i in range(DEPTH):
        lambda_init = 0.8 - 0.6 * math.exp(-0.3 * i)
        h = h + hybrid_mixer(rms_norm(h, g_attn[i]), positions, w_in[i],
                             lambda_q1[i], lambda_k1[i], lambda_q2[i], lambda_k2[i],
                             g_subln[i], b_forget[i], w_out[i], lambda_init)
        h = h + moe(rms_norm(h, g_moe[i]), w_router[i], b_router[i],
                    w_e1[i], b_e1[i], w_e2[i], b_e2[i])
        gate = jax.nn.sigmoid(rms_norm(h, g_ple[i]) @ w_ple_gate[i])
        h = h + gate * (p[i] @ w_ple_proj[i])
    return rms_norm(h, g_final)
```

```cpp
#include <hip/hip_runtime.h>
#include <hip/hip_cooperative_groups.h>
#include <cstdio>
#include <cstdint>
namespace cg = cooperative_groups;

constexpr int NB = 8, SEQ = 2048, D = 1024, M = NB * SEQ;
constexpr int INW = 3080, NPROJ = 3072;
constexpr int NE = 32, TOPK = 4, DE = 1024, PLE = 256;
constexpr float EPS = 1e-5f;
constexpr float LOG2E = 1.4426950408889634f;
constexpr float QSCALE = 0.125f * LOG2E;
constexpr float LAMBDA_INIT = 0.2f;
constexpr int NT = 512, NWAVE = 8;

typedef unsigned short bf16;
typedef short bf16x8 __attribute__((ext_vector_type(8)));
typedef float f32x4 __attribute__((ext_vector_type(4)));
typedef unsigned u32x4 __attribute__((ext_vector_type(4)));
typedef unsigned u32x2 __attribute__((ext_vector_type(2)));

constexpr size_t MiB = 1u << 20;
constexpr size_t WS_CTL = 0;
constexpr size_t WS_COS = 1 * MiB;
constexpr size_t WS_SIN = WS_COS + 512 * 1024;
constexpr size_t WS_LOGF = 2 * MiB;
constexpr size_t WS_CUM = WS_LOGF + 512 * 1024;
constexpr size_t WS_GATE = 3 * MiB;
constexpr size_t WS_LIST = 4 * MiB;
constexpr size_t WS_XN = 8 * MiB;
constexpr size_t WS_PROJ = 40 * MiB;
constexpr size_t WS_OATT = 136 * MiB;
constexpr size_t WS_MIXED = 184 * MiB;
constexpr size_t WS_H1 = 216 * MiB;
constexpr size_t WS_PP = 280 * MiB;
constexpr size_t WS_ACT = 312 * MiB;
constexpr size_t WS_Y = 456 * MiB;
constexpr size_t WS_H2 = 584 * MiB;
constexpr size_t WS_END = 648 * MiB;

struct P {
    const float* x; const float* p; const int* pos; const float* g_attn; const float* w_in;
    const float* lq1; const float* lk1; const float* lq2; const float* lk2; const float* g_subln; const float* b_forget;
    const float* w_out; const float* g_moe; const float* w_router; const float* b_router;
    const float* w_e1; const float* b_e1; const float* w_e2; const float* b_e2;
    const float* g_ple; const float* w_gate; const float* w_proj; const float* g_final;
    float* out; unsigned char* ws;
};

__device__ __forceinline__ unsigned f2bf(float f) { unsigned u = __builtin_bit_cast(unsigned, f); return (u + 0x7fffu + ((u >> 16) & 1u)) >> 16; }
__device__ __forceinline__ float bf2f(unsigned h) { return __builtin_bit_cast(float, h << 16); }
__device__ __forceinline__ unsigned pk2(float lo, float hi) { return f2bf(lo) | (f2bf(hi) << 16); }
__device__ __forceinline__ float wave_sum(float v) {
#pragma unroll
    for (int o = 1; o < 64; o <<= 1) v += __shfl_xor(v, o);
    return v;
}
__device__ __forceinline__ float sigmoidf_(float z) { return 1.0f / (1.0f + __expf(-z)); }

struct SgLds { bf16 a[128][40]; bf16 b[128][40]; };

template <bool A_F32, class RowPtr, class ColMap, class Epi>
__device__ __forceinline__ void sgemm_tile(SgLds& L, RowPtr rowptr, int K, const float* __restrict__ W, int ldw, ColMap colmap, Epi epi) {
    const int tid = threadIdx.x, lane = tid & 63, wid = tid >> 6, wr = wid >> 1, wc = wid & 1, fr = lane & 15, fq = lane >> 4;
    const int ar = tid >> 2, akc = (tid & 3) * 8;
    const void* aptr = rowptr(ar);
    const int bk = tid >> 4, bnc = (tid & 15) * 8;
    int wcol[8];
#pragma unroll
    for (int i = 0; i < 8; ++i) wcol[i] = colmap(bnc + i);
    f32x4 acc[2][4];
#pragma unroll
    for (int m = 0; m < 2; ++m)
#pragma unroll
        for (int n = 0; n < 4; ++n) acc[m][n] = (f32x4){0.f, 0.f, 0.f, 0.f};
    for (int k0 = 0; k0 < K; k0 += 32) {
        u32x4 av = (u32x4){0u, 0u, 0u, 0u};
        if (aptr) {
            if (A_F32) { const float* ap = (const float*)aptr + k0 + akc; const f32x4 v0 = *(const f32x4*)ap, v1 = *(const f32x4*)(ap + 4);
                av.x = pk2(v0.x, v0.y); av.y = pk2(v0.z, v0.w); av.z = pk2(v1.x, v1.y); av.w = pk2(v1.z, v1.w); }
            else av = *(const u32x4*)((const bf16*)aptr + k0 + akc);
        }
        float wv[8];
#pragma unroll
        for (int i = 0; i < 8; ++i) wv[i] = W[(size_t)(k0 + bk) * ldw + wcol[i]];
        __syncthreads();
        *(u32x4*)&L.a[ar][akc] = av;
#pragma unroll
        for (int i = 0; i < 8; ++i) L.b[bnc + i][bk] = (bf16)f2bf(wv[i]);
        __syncthreads();
        bf16x8 af[2], bfr[4];
#pragma unroll
        for (int m = 0; m < 2; ++m) af[m] = *(const bf16x8*)&L.a[wr * 32 + m * 16 + fr][fq * 8];
#pragma unroll
        for (int n = 0; n < 4; ++n) bfr[n] = *(const bf16x8*)&L.b[wc * 64 + n * 16 + fr][fq * 8];
#pragma unroll
        for (int m = 0; m < 2; ++m)
#pragma unroll
            for (int n = 0; n < 4; ++n) acc[m][n] = __builtin_amdgcn_mfma_f32_16x16x32_bf16(af[m], bfr[n], acc[m][n], 0, 0, 0);
    }
    epi(acc, wr, wc, fr, fq);
}

__device__ void ph_prologue(const P& p, int bid, int nb) {
    const int tid = threadIdx.x, lane = tid & 63, wave = tid >> 6;
    const int gw = bid * NWAVE + wave, ngw = nb * NWAVE;
    if (bid == 0 && tid < 64) ((unsigned*)(p.ws + WS_CTL))[tid] = 0u;
    bf16* XN = (bf16*)(p.ws + WS_XN);
    float* LOGF = (float*)(p.ws + WS_LOGF); float* COS = (float*)(p.ws + WS_COS); float* SIN = (float*)(p.ws + WS_SIN);
    for (int m = gw; m < M; m += ngw) {
        const f32x4* xr = (const f32x4*)(p.x + (size_t)m * D) + lane;
        f32x4 v[4]; float ss = 0.f;
#pragma unroll
        for (int j = 0; j < 4; ++j) { v[j] = xr[64 * j]; ss += (v[j].x * v[j].x + v[j].y * v[j].y) + (v[j].z * v[j].z + v[j].w * v[j].w); }
        const float rstd = 1.0f / sqrtf(wave_sum(ss) * (1.f / D) + EPS);
        float fz[8];
#pragma unroll
        for (int i = 0; i < 8; ++i) fz[i] = 0.f;
#pragma unroll
        for (int j = 0; j < 4; ++j) {
            const f32x4 g = ((const f32x4*)p.g_attn)[lane + 64 * j];
            v[j] = v[j] * rstd * g;
            const int k = 4 * lane + 256 * j;
#pragma unroll
            for (int e = 0; e < 4; ++e) {
                const float* wr_ = p.w_in + (size_t)(k + e) * INW + NPROJ;
                const f32x4 w0 = *(const f32x4*)wr_, w1 = *(const f32x4*)(wr_ + 4);
                const float y = v[j][e];
                fz[0] += y * w0.x; fz[1] += y * w0.y; fz[2] += y * w0.z; fz[3] += y * w0.w;
                fz[4] += y * w1.x; fz[5] += y * w1.y; fz[6] += y * w1.z; fz[7] += y * w1.w;
            }
            u32x2 o; o.x = pk2(v[j].x, v[j].y); o.y = pk2(v[j].z, v[j].w);
            *((u32x2*)(XN + (size_t)m * D) + lane + 64 * j) = o;
        }
#pragma unroll
        for (int i = 0; i < 8; ++i) fz[i] = wave_sum(fz[i]);
        if (lane < 8) {
            float z = 0.f;
#pragma unroll
            for (int i = 0; i < 8; ++i) z = (lane == i) ? fz[i] : z;
            z += p.b_forget[lane];
            LOGF[(size_t)m * 8 + lane] = fminf(z, 0.f) - log1pf(__expf(-fabsf(z)));
            const double invf = exp2(-(double)lane * 0.125 * 18.931568569324174);
            const double ang = (double)p.pos[m] * invf;
            const double kq = rint(ang * 0.15915494309189535);
            const double r = (ang - kq * 6.283185307179586) - kq * 2.4492935982947064e-16;
            const float rf = (float)r;
            COS[(size_t)m * 8 + lane] = cosf(rf); SIN[(size_t)m * 8 + lane] = sinf(rf);
        }
    }
}

__device__ void ph_inproj(const P& p, SgLds& L, int bid, int nb) {
    const int tid = threadIdx.x, lane = tid & 63, wave = tid >> 6;
    {
        const int gw = bid * NWAVE + wave;
        if (gw < NB * 8) {
            const int b = gw >> 3, h = gw & 7;
            const float* LOGF = (const float*)(p.ws + WS_LOGF); float* CUM = (float*)(p.ws + WS_CUM);
            float loc[32]; float s = 0.f;
#pragma unroll
            for (int i = 0; i < 32; ++i) { s += LOGF[(size_t)(b * SEQ + lane * 32 + i) * 8 + h]; loc[i] = s; }
            float inc = s;
#pragma unroll
            for (int o = 1; o < 64; o <<= 1) { const float t = __shfl_up(inc, o); if (lane >= o) inc += t; }
            const float excl = inc - s;
#pragma unroll
            for (int i = 0; i < 32; ++i) CUM[(size_t)(b * SEQ + lane * 32 + i) * 8 + h] = excl + loc[i];
        }
    }
    const bf16* XN = (const bf16*)(p.ws + WS_XN); bf16* PROJ = (bf16*)(p.ws + WS_PROJ); bf16* PP = (bf16*)(p.ws + WS_PP);
    const float* COS = (const float*)(p.ws + WS_COS); const float* SIN = (const float*)(p.ws + WS_SIN);
    constexpr int T_IN = (M / 128) * (NPROJ / 128), T_PP = (M / 128) * (D / 128);
    for (int t = bid; t < T_IN + T_PP; t += nb) {
        if (t < T_IN) {
            const int tm = t / (NPROJ / 128), tn = t % (NPROJ / 128), row0 = tm * 128, col0 = tn * 128;
            sgemm_tile<false>(L, [&](int r) -> const void* { return XN + (size_t)(row0 + r) * D; }, D, p.w_in, INW, [&](int c) { return col0 + c; },
                [&](f32x4 (&acc)[2][4], int wr, int wc, int fr, int fq) {
#pragma unroll
                    for (int m = 0; m < 2; ++m)
#pragma unroll
                        for (int n = 0; n < 4; ++n) {
                            const int col = col0 + wc * 64 + n * 16 + fr;
#pragma unroll
                            for (int j = 0; j < 4; ++j) {
                                const int row = row0 + wr * 32 + m * 16 + fq * 4 + j;
                                float v = acc[m][n][j];
                                if (col0 < 1024 && n == 0) {
                                    const float pr = __shfl_xor(v, 8);
                                    const float c = COS[(size_t)row * 8 + (fr & 7)], s = SIN[(size_t)row * 8 + (fr & 7)];
                                    v = (fr < 8) ? (v * c - pr * s) : (v * c + pr * s);
                                }
                                if (col0 < 512 || (col0 >= 1536 && col0 < 2048)) v *= QSCALE;
                                PROJ[(size_t)row * NPROJ + col] = (bf16)f2bf(v);
                            }
                        }
                });
        } else {
            const int u = t - T_IN, tm = u / (D / 128), tn = u % (D / 128), row0 = tm * 128, col0 = tn * 128;
            sgemm_tile<true>(L, [&](int r) -> const void* { return p.p + (size_t)(row0 + r) * PLE; }, PLE, p.w_proj, D, [&](int c) { return col0 + c; },
                [&](f32x4 (&acc)[2][4], int wr, int wc, int fr, int fq) {
#pragma unroll
                    for (int m = 0; m < 2; ++m)
#pragma unroll
                        for (int n = 0; n < 4; ++n)
#pragma unroll
                            for (int j = 0; j < 4; ++j) PP[(size_t)(row0 + wr * 32 + m * 16 + fq * 4 + j) * D + col0 + wc * 64 + n * 16 + fr] = (bf16)f2bf(acc[m][n][j]);
                });
        }
    }
}

__device__ void ph_attn(const P& p, int bid, int nb) {
    const int tid = threadIdx.x, lane = tid & 63, wave = tid >> 6;
    const int gw = bid * NWAVE + wave, ngw = nb * NWAVE;
    const bf16* PROJ = (const bf16*)(p.ws + WS_PROJ); const float* CUM = (const float*)(p.ws + WS_CUM);
    bf16* OATT = (bf16*)(p.ws + WS_OATT); bf16* MIXED = (bf16*)(p.ws + WS_MIXED);
    constexpr int NITEM = NB * 24 * (SEQ / 64);
    for (int it0 = gw; it0 < NITEM; it0 += ngw) {
        const int it = NITEM - 1 - it0;
        const int qc = it / (NB * 24), bp = it % (NB * 24), b = bp / 24, pr = bp % 24;
        int qcol, kcol, vcol, hf = -1; bf16* obase; int opitch = D;
        if (pr < 16) { const int h = pr >> 2, mm = (pr >> 1) & 1, vh = pr & 1; qcol = h * 128 + mm * 64; kcol = 512 + qcol; vcol = 1024 + h * 128 + vh * 64; obase = OATT + mm * 512 + h * 128 + vh * 64; }
        else { hf = pr - 16; qcol = 1536 + hf * 64; kcol = 2048 + hf * 64; vcol = 2560 + hf * 64; obase = MIXED + 512 + hf * 64; }
        const int q = qc * 64 + lane; const size_t rowq = (size_t)b * SEQ + q;
        float qv[64], o[64];
#pragma unroll
        for (int c = 0; c < 8; ++c) { const u32x4 w = *(const u32x4*)(PROJ + rowq * NPROJ + qcol + c * 8);
#pragma unroll
            for (int e = 0; e < 4; ++e) { qv[c * 8 + 2 * e] = bf2f(w[e] & 0xffffu); qv[c * 8 + 2 * e + 1] = bf2f(w[e] >> 16); } }
#pragma unroll
        for (int d = 0; d < 64; ++d) o[d] = 0.f;
        const float cq = (hf >= 0) ? CUM[rowq * 8 + hf] * LOG2E : 0.f;
        float mx = -INFINITY, l = 0.f;
        const int jend = qc * 64 + 63;
        for (int j = 0; j <= jend; ++j) {
            const size_t rowk = (size_t)b * SEQ + j;
            float s = 0.f;
#pragma unroll
            for (int c = 0; c < 8; ++c) { const u32x4 w = *(const u32x4*)(PROJ + rowk * NPROJ + kcol + c * 8);
#pragma unroll
                for (int e = 0; e < 4; ++e) { s += qv[c * 8 + 2 * e] * bf2f(w[e] & 0xffffu); s += qv[c * 8 + 2 * e + 1] * bf2f(w[e] >> 16); } }
            if (hf >= 0) s += cq - CUM[rowk * 8 + hf] * LOG2E;
            if (j > q) s = -INFINITY;
            const float mn = fmaxf(mx, s);
            const float corr = (mn == -INFINITY) ? 1.f : exp2f(mx - mn);
            const float pe = (s == -INFINITY) ? 0.f : exp2f(s - mn);
            mx = mn; l = l * corr + pe;
#pragma unroll
            for (int c = 0; c < 8; ++c) { const u32x4 w = *(const u32x4*)(PROJ + rowk * NPROJ + vcol + c * 8);
#pragma unroll
                for (int e = 0; e < 4; ++e) { o[c * 8 + 2 * e] = o[c * 8 + 2 * e] * corr + pe * bf2f(w[e] & 0xffffu); o[c * 8 + 2 * e + 1] = o[c * 8 + 2 * e + 1] * corr + pe * bf2f(w[e] >> 16); } }
        }
        const float rl = 1.f / l;
#pragma unroll
        for (int c = 0; c < 8; ++c) { u32x4 w;
#pragma unroll
            for (int e = 0; e < 4; ++e) w[e] = pk2(o[c * 8 + 2 * e] * rl, o[c * 8 + 2 * e + 1] * rl);
            *(u32x4*)(obase + rowq * opitch + c * 8) = w; }
    }
}

__device__ void ph_combine(const P& p, int bid, int nb) {
    const int tid = threadIdx.x, lane = tid & 63, wave = tid >> 6;
    const int gw = bid * NWAVE + wave, ngw = nb * NWAVE;
    const float lam = __expf(wave_sum(p.lq1[lane] * p.lk1[lane])) - __expf(wave_sum(p.lq2[lane] * p.lk2[lane])) + LAMBDA_INIT;
    const bf16* OATT = (const bf16*)(p.ws + WS_OATT); bf16* MIXED = (bf16*)(p.ws + WS_MIXED);
    const float g0 = p.g_subln[2 * lane], g1 = p.g_subln[2 * lane + 1];
    for (int m = gw; m < M; m += ngw) {
#pragma unroll
        for (int h = 0; h < 4; ++h) {
            const unsigned a = *(const unsigned*)(OATT + (size_t)m * D + h * 128 + 2 * lane), c = *(const unsigned*)(OATT + (size_t)m * D + 512 + h * 128 + 2 * lane);
            const float d0 = bf2f(a & 0xffffu) - lam * bf2f(c & 0xffffu), d1 = bf2f(a >> 16) - lam * bf2f(c >> 16);
            const float rstd = 1.0f / sqrtf(wave_sum(d0 * d0 + d1 * d1) * (1.f / 128.f) + EPS);
            *(unsigned*)(MIXED + (size_t)m * D + h * 128 + 2 * lane) = pk2(d0 * rstd * g0 * (1.f - LAMBDA_INIT), d1 * rstd * g1 * (1.f - LAMBDA_INIT));
        }
    }
}

__device__ void ph_outproj(const P& p, SgLds& L, int bid, int nb) {
    const bf16* MIXED = (const bf16*)(p.ws + WS_MIXED); float* H1 = (float*)(p.ws + WS_H1);
    constexpr int T = (M / 128) * (D / 128);
    for (int t = bid; t < T; t += nb) {
        const int tm = t / (D / 128), tn = t % (D / 128), row0 = tm * 128, col0 = tn * 128;
        sgemm_tile<false>(L, [&](int r) -> const void* { return MIXED + (size_t)(row0 + r) * D; }, D, p.w_out, D, [&](int c) { return col0 + c; },
            [&](f32x4 (&acc)[2][4], int wr, int wc, int fr, int fq) {
#pragma unroll
                for (int m = 0; m < 2; ++m)
#pragma unroll
                    for (int n = 0; n < 4; ++n)
#pragma unroll
                        for (int j = 0; j < 4; ++j) { const size_t idx = (size_t)(row0 + wr * 32 + m * 16 + fq * 4 + j) * D + col0 + wc * 64 + n * 16 + fr; H1[idx] = p.x[idx] + acc[m][n][j]; }
            });
    }
}

__device__ void ph_route(const P& p, int bid, int nb) {
    const int tid = threadIdx.x, lane = tid & 63, wave = tid >> 6;
    const int gw = bid * NWAVE + wave, ngw = nb * NWAVE;
    const float* H1 = (const float*)(p.ws + WS_H1); bf16* XN = (bf16*)(p.ws + WS_XN);
    unsigned* CNT = (unsigned*)(p.ws + WS_CTL); int* LIST = (int*)(p.ws + WS_LIST); float* GATE = (float*)(p.ws + WS_GATE);
    for (int m = gw; m < M; m += ngw) {
        const f32x4* xr = (const f32x4*)(H1 + (size_t)m * D) + lane;
        f32x4 v[4]; float ss = 0.f;
#pragma unroll
        for (int j = 0; j < 4; ++j) { v[j] = xr[64 * j]; ss += (v[j].x * v[j].x + v[j].y * v[j].y) + (v[j].z * v[j].z + v[j].w * v[j].w); }
        const float rstd = 1.0f / sqrtf(wave_sum(ss) * (1.f / D) + EPS);
        float lg[32];
#pragma unroll
        for (int e = 0; e < 32; ++e) lg[e] = 0.f;
#pragma unroll
        for (int j = 0; j < 4; ++j) {
            const f32x4 g = ((const f32x4*)p.g_moe)[lane + 64 * j];
            v[j] = v[j] * rstd * g;
            const int k = 4 * lane + 256 * j;
#pragma unroll
            for (int e4 = 0; e4 < 4; ++e4) {
                const f32x4* wr_ = (const f32x4*)(p.w_router + (size_t)(k + e4) * NE);
                const float y = v[j][e4];
#pragma unroll
                for (int q = 0; q < 8; ++q) { const f32x4 w = wr_[q]; lg[4 * q] += y * w.x; lg[4 * q + 1] += y * w.y; lg[4 * q + 2] += y * w.z; lg[4 * q + 3] += y * w.w; }
            }
            u32x2 o; o.x = pk2(v[j].x, v[j].y); o.y = pk2(v[j].z, v[j].w);
            *((u32x2*)(XN + (size_t)m * D) + lane + 64 * j) = o;
        }
#pragma unroll
        for (int e = 0; e < 32; ++e) lg[e] = wave_sum(lg[e]) + p.b_router[e];
        int idx[4]; float val[4];
#pragma unroll
        for (int k = 0; k < 4; ++k) {
            float best = -INFINITY; int bi = 0;
#pragma unroll
            for (int e = 0; e < 32; ++e) { const bool take = lg[e] > best; best = take ? lg[e] : best; bi = take ? e : bi; }
            idx[k] = bi; val[k] = best;
#pragma unroll
            for (int e = 0; e < 32; ++e) lg[e] = (e == bi) ? -INFINITY : lg[e];
        }
        const float e1 = __expf(val[1] - val[0]), e2 = __expf(val[2] - val[0]), e3 = __expf(val[3] - val[0]);
        const float rs = 1.f / (1.f + e1 + e2 + e3);
        if (lane < 4) {
            const int e = lane == 0 ? idx[0] : lane == 1 ? idx[1] : lane == 2 ? idx[2] : idx[3];
            const float gt = (lane == 0 ? 1.f : lane == 1 ? e1 : lane == 2 ? e2 : e3) * rs;
            const unsigned pos = atomicAdd(&CNT[e], 1u);
            LIST[e * M + pos] = m * 4 + lane;
            GATE[(size_t)m * 4 + lane] = gt;
        }
    }
}

struct MoeSched { int cnt[NE]; };
__device__ __forceinline__ bool moe_tile(const unsigned* CNT, int t, int ntn, int& e, int& mt, int& tn, int& rowbase, int& cnt_e) {
    int base = 0, acc = 0;
    for (int i = 0; i < NE; ++i) {
        const int c = (int)CNT[i], tiles = (c + 127) >> 7;
        if (t < acc + tiles * ntn) { e = i; const int u = t - acc; mt = u / ntn; tn = u % ntn; rowbase = base; cnt_e = c; return true; }
        acc += tiles * ntn; base += tiles * 128;
    }
    return false;
}
__device__ void ph_moe1(const P& p, SgLds& L, int bid, int nb) {
    const unsigned* CNT = (const unsigned*)(p.ws + WS_CTL); const int* LIST = (const int*)(p.ws + WS_LIST);
    const bf16* XN = (const bf16*)(p.ws + WS_XN); bf16* ACT = (bf16*)(p.ws + WS_ACT);
    for (int t = bid;; t += nb) {
        int e, mt, tn, rowbase, cnt_e;
        if (!moe_tile(CNT, t, 16, e, mt, tn, rowbase, cnt_e)) break;
        const float* W = p.w_e1 + (size_t)e * D * 2 * DE; const float* B1 = p.b_e1 + (size_t)e * 2 * DE;
        sgemm_tile<false>(L, [&](int r) -> const void* { const int rr = mt * 128 + r; return rr < cnt_e ? (const void*)(XN + (size_t)(LIST[e * M + rr] >> 2) * D) : nullptr; }, D, W, 2 * DE,
            [&](int c) { const int wc = c >> 6, n = (c >> 4) & 3, i = c & 15; return 2 * (tn * 64 + wc * 32 + (n & 1) * 16 + i) + (n >> 1); },
            [&](f32x4 (&acc)[2][4], int wr, int wc, int fr, int fq) {
#pragma unroll
                for (int m = 0; m < 2; ++m)
#pragma unroll
                    for (int n = 0; n < 2; ++n) {
                        const int ac = tn * 64 + wc * 32 + n * 16 + fr; const float bg = B1[2 * ac], bl = B1[2 * ac + 1];
#pragma unroll
                        for (int j = 0; j < 4; ++j) {
                            const int row = rowbase + mt * 128 + wr * 32 + m * 16 + fq * 4 + j;
                            const float glu = fminf(acc[m][n][j] + bg, 7.0f), lin = fminf(fmaxf(acc[m][n + 2][j] + bl, -7.0f), 7.0f);
                            ACT[(size_t)row * DE + ac] = (bf16)f2bf(glu * sigmoidf_(1.702f * glu) * (lin + 1.0f));
                        }
                    }
            });
    }
}
__device__ void ph_moe2(const P& p, SgLds& L, int bid, int nb) {
    const unsigned* CNT = (const unsigned*)(p.ws + WS_CTL); const int* LIST = (const int*)(p.ws + WS_LIST);
    const bf16* ACT = (const bf16*)(p.ws + WS_ACT); bf16* Y = (bf16*)(p.ws + WS_Y);
    for (int t = bid;; t += nb) {
        int e, mt, tn, rowbase, cnt_e;
        if (!moe_tile(CNT, t, 8, e, mt, tn, rowbase, cnt_e)) break;
        const float* W = p.w_e2 + (size_t)e * DE * D; const float* B2 = p.b_e2 + (size_t)e * D;
        const int col0 = tn * 128;
        sgemm_tile<false>(L, [&](int r) -> const void* { return ACT + (size_t)(rowbase + mt * 128 + r) * DE; }, DE, W, D, [&](int c) { return col0 + c; },
            [&](f32x4 (&acc)[2][4], int wr, int wc, int fr, int fq) {
#pragma unroll
                for (int m = 0; m < 2; ++m)
#pragma unroll
                    for (int j = 0; j < 4; ++j) {
                        const int rr = mt * 128 + wr * 32 + m * 16 + fq * 4 + j;
                        if (rr < cnt_e) { const int slot = LIST[e * M + rr];
#pragma unroll
                            for (int n = 0; n < 4; ++n) { const int col = col0 + wc * 64 + n * 16 + fr; Y[(size_t)slot * D + col] = (bf16)f2bf(acc[m][n][j] + B2[col]); } }
                    }
            });
    }
}

__device__ void ph_combine2(const P& p, int bid, int nb) {
    const int tid = threadIdx.x, lane = tid & 63, wave = tid >> 6;
    const int gw = bid * NWAVE + wave, ngw = nb * NWAVE;
    const float* H1 = (const float*)(p.ws + WS_H1); float* H2 = (float*)(p.ws + WS_H2); bf16* XN = (bf16*)(p.ws + WS_XN);
    const bf16* Y = (const bf16*)(p.ws + WS_Y); const float* GATE = (const float*)(p.ws + WS_GATE);
    for (int m = gw; m < M; m += ngw) {
        const f32x4 gt = *(const f32x4*)(GATE + (size_t)m * 4);
        f32x4 v[4]; float ss = 0.f;
#pragma unroll
        for (int j = 0; j < 4; ++j) {
            v[j] = ((const f32x4*)(H1 + (size_t)m * D))[lane + 64 * j];
#pragma unroll
            for (int k = 0; k < 4; ++k) {
                const u32x2 w = *((const u32x2*)(Y + (size_t)(m * 4 + k) * D) + lane + 64 * j);
                const float g = gt[k];
                v[j].x += g * bf2f(w.x & 0xffffu); v[j].y += g * bf2f(w.x >> 16); v[j].z += g * bf2f(w.y & 0xffffu); v[j].w += g * bf2f(w.y >> 16);
            }
            ((f32x4*)(H2 + (size_t)m * D))[lane + 64 * j] = v[j];
            ss += (v[j].x * v[j].x + v[j].y * v[j].y) + (v[j].z * v[j].z + v[j].w * v[j].w);
        }
        const float rstd = 1.0f / sqrtf(wave_sum(ss) * (1.f / D) + EPS);
#pragma unroll
        for (int j = 0; j < 4; ++j) {
            const f32x4 g = ((const f32x4*)p.g_ple)[lane + 64 * j];
            const f32x4 y = v[j] * rstd * g;
            u32x2 o; o.x = pk2(y.x, y.y); o.y = pk2(y.z, y.w);
            *((u32x2*)(XN + (size_t)m * D) + lane + 64 * j) = o;
        }
    }
}

__device__ void ph_gate(const P& p, SgLds& L, int bid, int nb) {
    const bf16* XN = (const bf16*)(p.ws + WS_XN); const float* H2 = (const float*)(p.ws + WS_H2); const bf16* PP = (const bf16*)(p.ws + WS_PP);
    constexpr int T = (M / 128) * (D / 128);
    for (int t = bid; t < T; t += nb) {
        const int tm = t / (D / 128), tn = t % (D / 128), row0 = tm * 128, col0 = tn * 128;
        sgemm_tile<false>(L, [&](int r) -> const void* { return XN + (size_t)(row0 + r) * D; }, D, p.w_gate, D, [&](int c) { return col0 + c; },
            [&](f32x4 (&acc)[2][4], int wr, int wc, int fr, int fq) {
#pragma unroll
                for (int m = 0; m < 2; ++m)
#pragma unroll
                    for (int n = 0; n < 4; ++n)
#pragma unroll
                        for (int j = 0; j < 4; ++j) { const size_t idx = (size_t)(row0 + wr * 32 + m * 16 + fq * 4 + j) * D + col0 + wc * 64 + n * 16 + fr;
                            p.out[idx] = H2[idx] + sigmoidf_(acc[m][n][j]) * bf2f(PP[idx]); }
            });
    }
}

__device__ void ph_final(const P& p, int bid, int nb) {
    const int tid = threadIdx.x, lane = tid & 63, wave = tid >> 6;
    const int gw = bid * NWAVE + wave, ngw = nb * NWAVE;
    for (int m = gw; m < M; m += ngw) {
        f32x4* xr = (f32x4*)(p.out + (size_t)m * D) + lane;
        f32x4 v[4]; float ss = 0.f;
#pragma unroll
        for (int j = 0; j < 4; ++j) { v[j] = xr[64 * j]; ss += (v[j].x * v[j].x + v[j].y * v[j].y) + (v[j].z * v[j].z + v[j].w * v[j].w); }
        const float rstd = 1.0f / sqrtf(wave_sum(ss) * (1.f / D) + EPS);
#pragma unroll
        for (int j = 0; j < 4; ++j) xr[64 * j] = v[j] * rstd * ((const f32x4*)p.g_final)[lane + 64 * j];
    }
}

constexpr int NPHASE = 11;
__device__ __forceinline__ void run_phase(const P& p, SgLds& L, int ph, int bid, int nb) {
    switch (ph) {
        case 0: ph_prologue(p, bid, nb); break;
        case 1: ph_inproj(p, L, bid, nb); break;
        case 2: ph_attn(p, bid, nb); break;
        case 3: ph_combine(p, bid, nb); break;
        case 4: ph_outproj(p, L, bid, nb); break;
        case 5: ph_route(p, bid, nb); break;
        case 6: ph_moe1(p, L, bid, nb); break;
        case 7: ph_moe2(p, L, bid, nb); break;
        case 8: ph_combine2(p, bid, nb); break;
        case 9: ph_gate(p, L, bid, nb); break;
        default: ph_final(p, bid, nb); break;
    }
}

__global__ void __launch_bounds__(NT) k_phase(P p, int ph) {
    __shared__ SgLds L;
    run_phase(p, L, ph, blockIdx.x, gridDim.x);
}

extern "C" void kernel_launch(void* const* d_in, const int* in_sizes, int n_in, void* d_out, int out_size, void* d_ws, size_t ws_size, hipStream_t stream) {
    if (n_in != 23 || in_sizes[0] != M * D || out_size != M * D || ws_size < WS_END) {
        fprintf(stderr, "kernel_launch: unexpected shapes (n_in %d in0 %d out %d ws %zu)\n", n_in, n_in > 0 ? in_sizes[0] : -1, out_size, ws_size); return; }
    P p{};
    p.x = (const float*)d_in[0]; p.p = (const float*)d_in[1]; p.pos = (const int*)d_in[2]; p.g_attn = (const float*)d_in[3]; p.w_in = (const float*)d_in[4];
    p.lq1 = (const float*)d_in[5]; p.lk1 = (const float*)d_in[6]; p.lq2 = (const float*)d_in[7]; p.lk2 = (const float*)d_in[8]; p.g_subln = (const float*)d_in[9];
    p.b_forget = (const float*)d_in[10]; p.w_out = (const float*)d_in[11]; p.g_moe = (const float*)d_in[12]; p.w_router = (const float*)d_in[13]; p.b_router = (const float*)d_in[14];
    p.w_e1 = (const float*)d_in[15]; p.b_e1 = (const float*)d_in[16]; p.w_e2 = (const float*)d_in[17]; p.b_e2 = (const float*)d_in[18];
    p.g_ple = (const float*)d_in[19]; p.w_gate = (const float*)d_in[20]; p.w_proj = (const float*)d_in[21]; p.g_final = (const float*)d_in[22];
    p.out = (float*)d_out; p.ws = (unsigned char*)d_ws;
    for (int ph = 0; ph < NPHASE; ++ph) hipLaunchKernelGGL(k_phase, dim3(1024), dim3(NT), 0, stream, p, ph);
}
```

```cpp
#include <hip/hip_runtime.h>
#include <hip/hip_cooperative_groups.h>
#include <cstdio>
#include <cstdint>
namespace cg = cooperative_groups;

constexpr int NB = 8, SEQ = 2048, D = 1024, M = NB * SEQ;
constexpr int INW = 3080, NPROJ = 3072;
constexpr int NE = 32, TOPK = 4, DE = 1024, PLE = 256;
constexpr float EPS = 1e-5f;
constexpr float LOG2E = 1.4426950408889634f;
constexpr float QSCALE = 0.125f * LOG2E;
constexpr float LAMBDA_INIT = 0.2f;
constexpr int NT = 512, NWAVE = 8;

typedef unsigned short bf16;
typedef short bf16x8 __attribute__((ext_vector_type(8)));
typedef float f32x4 __attribute__((ext_vector_type(4)));
typedef unsigned u32x4 __attribute__((ext_vector_type(4)));
typedef unsigned u32x2 __attribute__((ext_vector_type(2)));

constexpr size_t MiB = 1u << 20;
constexpr size_t WS_CTL = 0;
constexpr size_t WS_COS = 1 * MiB;
constexpr size_t WS_SIN = WS_COS + 512 * 1024;
constexpr size_t WS_LOGF = 2 * MiB;
constexpr size_t WS_CUM = WS_LOGF + 512 * 1024;
constexpr size_t WS_GATE = 3 * MiB;
constexpr size_t WS_LIST = 4 * MiB;
constexpr size_t WS_XN = 8 * MiB;
constexpr size_t WS_PROJ = 40 * MiB;
constexpr size_t WS_OATT = 136 * MiB;
constexpr size_t WS_MIXED = 184 * MiB;
constexpr size_t WS_H1 = 216 * MiB;
constexpr size_t WS_PP = 280 * MiB;
constexpr size_t WS_ACT = 312 * MiB;
constexpr size_t WS_Y = 456 * MiB;
constexpr size_t WS_H2 = 584 * MiB;
constexpr size_t WS_END = 648 * MiB;

struct P {
    const float* x; const float* p; const int* pos; const float* g_attn; const float* w_in;
    const float* lq1; const float* lk1; const float* lq2; const float* lk2; const float* g_subln; const float* b_forget;
    const float* w_out; const float* g_moe; const float* w_router; const float* b_router;
    const float* w_e1; const float* b_e1; const float* w_e2; const float* b_e2;
    const float* g_ple; const float* w_gate; const float* w_proj; const float* g_final;
    float* out; unsigned char* ws;
};

__device__ __forceinline__ unsigned f2bf(float f) { unsigned u = __builtin_bit_cast(unsigned, f); return (u + 0x7fffu + ((u >> 16) & 1u)) >> 16; }
__device__ __forceinline__ float bf2f(unsigned h) { return __builtin_bit_cast(float, h << 16); }
__device__ __forceinline__ unsigned pk2(float lo, float hi) { return f2bf(lo) | (f2bf(hi) << 16); }
__device__ __forceinline__ float wave_sum(float v) {
#pragma unroll
    for (int o = 1; o < 64; o <<= 1) v += __shfl_xor(v, o);
    return v;
}
__device__ __forceinline__ float sigmoidf_(float z) { return 1.0f / (1.0f + __expf(-z)); }

struct SgLds { bf16 a[128][40]; bf16 b[128][40]; };

template <bool A_F32, class RowPtr, class ColMap, class Epi>
__device__ __forceinline__ void sgemm_tile(SgLds& L, RowPtr rowptr, int K, const float* __restrict__ W, int ldw, ColMap colmap, Epi epi) {
    const int tid = threadIdx.x, lane = tid & 63, wid = tid >> 6, wr = wid >> 1, wc = wid & 1, fr = lane & 15, fq = lane >> 4;
    const int ar = tid >> 2, akc = (tid & 3) * 8;
    const void* aptr = rowptr(ar);
    const int bk = tid >> 4, bnc = (tid & 15) * 8;
    int wcol[8];
#pragma unroll
    for (int i = 0; i < 8; ++i) wcol[i] = colmap(bnc + i);
    f32x4 acc[2][4];
#pragma unroll
    for (int m = 0; m < 2; ++m)
#pragma unroll
        for (int n = 0; n < 4; ++n) acc[m][n] = (f32x4){0.f, 0.f, 0.f, 0.f};
    for (int k0 = 0; k0 < K; k0 += 32) {
        u32x4 av = (u32x4){0u, 0u, 0u, 0u};
        if (aptr) {
            if (A_F32) { const float* ap = (const float*)aptr + k0 + akc; const f32x4 v0 = *(const f32x4*)ap, v1 = *(const f32x4*)(ap + 4);
                av.x = pk2(v0.x, v0.y); av.y = pk2(v0.z, v0.w); av.z = pk2(v1.x, v1.y); av.w = pk2(v1.z, v1.w); }
            else av = *(const u32x4*)((const bf16*)aptr + k0 + akc);
        }
        float wv[8];
#pragma unroll
        for (int i = 0; i < 8; ++i) wv[i] = W[(size_t)(k0 + bk) * ldw + wcol[i]];
        __syncthreads();
        *(u32x4*)&L.a[ar][akc] = av;
#pragma unroll
        for (int i = 0; i < 8; ++i) L.b[bnc + i][bk] = (bf16)f2bf(wv[i]);
        __syncthreads();
        bf16x8 af[2], bfr[4];
#pragma unroll
        for (int m = 0; m < 2; ++m) af[m] = *(const bf16x8*)&L.a[wr * 32 + m * 16 + fr][fq * 8];
#pragma unroll
        for (int n = 0; n < 4; ++n) bfr[n] = *(const bf16x8*)&L.b[wc * 64 + n * 16 + fr][fq * 8];
#pragma unroll
        for (int m = 0; m < 2; ++m)
#pragma unroll
            for (int n = 0; n < 4; ++n) acc[m][n] = __builtin_amdgcn_mfma_f32_16x16x32_bf16(af[m], bfr[n], acc[m][n], 0, 0, 0);
    }
    epi(acc, wr, wc, fr, fq);
}

__device__ void ph_prologue(const P& p, int bid, int nb) {
    const int tid = threadIdx.x, lane = tid & 63, wave = tid >> 6;
    const int gw = bid * NWAVE + wave, ngw = nb * NWAVE;
    if (bid == 0 && tid < 64) ((unsigned*)(p.ws + WS_CTL))[tid] = 0u;
    bf16* XN = (bf16*)(p.ws + WS_XN);
    float* LOGF = (float*)(p.ws + WS_LOGF); float* COS = (float*)(p.ws + WS_COS); float* SIN = (float*)(p.ws + WS_SIN);
    for (int m = gw; m < M; m += ngw) {
        const f32x4* xr = (const f32x4*)(p.x + (size_t)m * D) + lane;
        f32x4 v[4]; float ss = 0.f;
#pragma unroll
        for (int j = 0; j < 4; ++j) { v[j] = xr[64 * j]; ss += (v[j].x * v[j].x + v[j].y * v[j].y) + (v[j].z * v[j].z + v[j].w * v[j].w); }
        const float rstd = 1.0f / sqrtf(wave_sum(ss) * (1.f / D) + EPS);
        float fz[8];
#pragma unroll
        for (int i = 0; i < 8; ++i) fz[i] = 0.f;
#pragma unroll
        for (int j = 0; j < 4; ++j) {
            const f32x4 g = ((const f32x4*)p.g_attn)[lane + 64 * j];
            v[j] = v[j] * rstd * g;
            const int k = 4 * lane + 256 * j;
#pragma unroll
            for (int e = 0; e < 4; ++e) {
                const float* wr_ = p.w_in + (size_t)(k + e) * INW + NPROJ;
                const f32x4 w0 = *(const f32x4*)wr_, w1 = *(const f32x4*)(wr_ + 4);
                const float y = v[j][e];
                fz[0] += y * w0.x; fz[1] += y * w0.y; fz[2] += y * w0.z; fz[3] += y * w0.w;
                fz[4] += y * w1.x; fz[5] += y * w1.y; fz[6] += y * w1.z; fz[7] += y * w1.w;
            }
            u32x2 o; o.x = pk2(v[j].x, v[j].y); o.y = pk2(v[j].z, v[j].w);
            *((u32x2*)(XN + (size_t)m * D) + lane + 64 * j) = o;
        }
#pragma unroll
        for (int i = 0; i < 8; ++i) fz[i] = wave_sum(fz[i]);
        if (lane < 8) {
            float z = 0.f;
#pragma unroll
            for (int i = 0; i < 8; ++i) z = (lane == i) ? fz[i] : z;
            z += p.b_forget[lane];
            LOGF[(size_t)m * 8 + lane] = fminf(z, 0.f) - log1pf(__expf(-fabsf(z)));
            const double invf = exp2(-(double)lane * 0.125 * 18.931568569324174);
            const double ang = (double)p.pos[m] * invf;
            const double kq = rint(ang * 0.15915494309189535);
            const double r = (ang - kq * 6.283185307179586) - kq * 2.4492935982947064e-16;
            const float rf = (float)r;
            COS[(size_t)m * 8 + lane] = cosf(rf); SIN[(size_t)m * 8 + lane] = sinf(rf);
        }
    }
}

__device__ void ph_inproj(const P& p, SgLds& L, int bid, int nb) {
    const int tid = threadIdx.x, lane = tid & 63, wave = tid >> 6;
    {
        const int gw = bid * NWAVE + wave;
        if (gw < NB * 8) {
            const int b = gw >> 3, h = gw & 7;
            const float* LOGF = (const float*)(p.ws + WS_LOGF); float* CUM = (float*)(p.ws + WS_CUM);
            float loc[32]; float s = 0.f;
#pragma unroll
            for (int i = 0; i < 32; ++i) { s += LOGF[(size_t)(b * SEQ + lane * 32 + i) * 8 + h]; loc[i] = s; }
            float inc = s;
#pragma unroll
            for (int o = 1; o < 64; o <<= 1) { const float t = __shfl_up(inc, o); if (lane >= o) inc += t; }
            const float excl = inc - s;
#pragma unroll
            for (int i = 0; i < 32; ++i) CUM[(size_t)(b * SEQ + lane * 32 + i) * 8 + h] = excl + loc[i];
        }
    }
    const bf16* XN = (const bf16*)(p.ws + WS_XN); bf16* PROJ = (bf16*)(p.ws + WS_PROJ); bf16* PP = (bf16*)(p.ws + WS_PP);
    const float* COS = (const float*)(p.ws + WS_COS); const float* SIN = (const float*)(p.ws + WS_SIN);
    constexpr int T_IN = (M / 128) * (NPROJ / 128), T_PP = (M / 128) * (D / 128);
    for (int t = bid; t < T_IN + T_PP; t += nb) {
        if (t < T_IN) {
            const int tm = t / (NPROJ / 128), tn = t % (NPROJ / 128), row0 = tm * 128, col0 = tn * 128;
            sgemm_tile<false>(L, [&](int r) -> const void* { return XN + (size_t)(row0 + r) * D; }, D, p.w_in, INW, [&](int c) { return col0 + c; },
                [&](f32x4 (&acc)[2][4], int wr, int wc, int fr, int fq) {
#pragma unroll
                    for (int m = 0; m < 2; ++m)
#pragma unroll
                        for (int n = 0; n < 4; ++n) {
                            const int col = col0 + wc * 64 + n * 16 + fr;
#pragma unroll
                            for (int j = 0; j < 4; ++j) {
                                const int row = row0 + wr * 32 + m * 16 + fq * 4 + j;
                                float v = acc[m][n][j];
                                if (col0 < 1024 && n == 0) {
                                    const float pr = __shfl_xor(v, 8);
                                    const float c = COS[(size_t)row * 8 + (fr & 7)], s = SIN[(size_t)row * 8 + (fr & 7)];
                                    v = (fr < 8) ? (v * c - pr * s) : (v * c + pr * s);
                                }
                                if (col0 < 512 || (col0 >= 1536 && col0 < 2048)) v *= QSCALE;
                                PROJ[(size_t)row * NPROJ + col] = (bf16)f2bf(v);
                            }
                        }
                });
        } else {
            const int u = t - T_IN, tm = u / (D / 128), tn = u % (D / 128), row0 = tm * 128, col0 = tn * 128;
            sgemm_tile<true>(L, [&](int r) -> const void* { return p.p + (size_t)(row0 + r) * PLE; }, PLE, p.w_proj, D, [&](int c) { return col0 + c; },
                [&](f32x4 (&acc)[2][4], int wr, int wc, int fr, int fq) {
#pragma unroll
                    for (int m = 0; m < 2; ++m)
#pragma unroll
                        for (int n = 0; n < 4; ++n)
#pragma unroll
                            for (int j = 0; j < 4; ++j) PP[(size_t)(row0 + wr * 32 + m * 16 + fq * 4 + j) * D + col0 + wc * 64 + n * 16 + fr] = (bf16)f2bf(acc[m][n][j]);
                });
        }
    }
}

__device__ void ph_attn(const P& p, int bid, int nb) {
    const int tid = threadIdx.x, lane = tid & 63, wave = tid >> 6;
    const int gw = bid * NWAVE + wave, ngw = nb * NWAVE;
    const bf16* PROJ = (const bf16*)(p.ws + WS_PROJ); const float* CUM = (const float*)(p.ws + WS_CUM);
    bf16* OATT = (bf16*)(p.ws + WS_OATT); bf16* MIXED = (bf16*)(p.ws + WS_MIXED);
    constexpr int NITEM = NB * 24 * (SEQ / 64);
    for (int it0 = gw; it0 < NITEM; it0 += ngw) {
        const int it = NITEM - 1 - it0;
        const int qc = it / (NB * 24), bp = it % (NB * 24), b = bp / 24, pr = bp % 24;
        int qcol, kcol, vcol, hf = -1; bf16* obase; int opitch = D;
        if (pr < 16) { const int h = pr >> 2, mm = (pr >> 1) & 1, vh = pr & 1; qcol = h * 128 + mm * 64; kcol = 512 + qcol; vcol = 1024 + h * 128 + vh * 64; obase = OATT + mm * 512 + h * 128 + vh * 64; }
        else { hf = pr - 16; qcol = 1536 + hf * 64; kcol = 2048 + hf * 64; vcol = 2560 + hf * 64; obase = MIXED + 512 + hf * 64; }
        const int q = qc * 64 + lane; const size_t rowq = (size_t)b * SEQ + q;
        float qv[64], o[64];
#pragma unroll
        for (int c = 0; c < 8; ++c) { const u32x4 w = *(const u32x4*)(PROJ + rowq * NPROJ + qcol + c * 8);
#pragma unroll
            for (int e = 0; e < 4; ++e) { qv[c * 8 + 2 * e] = bf2f(w[e] & 0xffffu); qv[c * 8 + 2 * e + 1] = bf2f(w[e] >> 16); } }
#pragma unroll
        for (int d = 0; d < 64; ++d) o[d] = 0.f;
        const float cq = (hf >= 0) ? CUM[rowq * 8 + hf] * LOG2E : 0.f;
        float mx = -INFINITY, l = 0.f;
        const int jend = qc * 64 + 63;
        for (int j = 0; j <= jend; ++j) {
            const size_t rowk = (size_t)b * SEQ + j;
            float s = 0.f;
#pragma unroll
            for (int c = 0; c < 8; ++c) { const u32x4 w = *(const u32x4*)(PROJ + rowk * NPROJ + kcol + c * 8);
#pragma unroll
                for (int e = 0; e < 4; ++e) { s += qv[c * 8 + 2 * e] * bf2f(w[e] & 0xffffu); s += qv[c * 8 + 2 * e + 1] * bf2f(w[e] >> 16); } }
            if (hf >= 0) s += cq - CUM[rowk * 8 + hf] * LOG2E;
            if (j > q) s = -INFINITY;
            const float mn = fmaxf(mx, s);
            const float corr = (mn == -INFINITY) ? 1.f : exp2f(mx - mn);
            const float pe = (s == -INFINITY) ? 0.f : exp2f(s - mn);
            mx = mn; l = l * corr + pe;
#pragma unroll
            for (int c = 0; c < 8; ++c) { const u32x4 w = *(const u32x4*)(PROJ + rowk * NPROJ + vcol + c * 8);
#pragma unroll
                for (int e = 0; e < 4; ++e) { o[c * 8 + 2 * e] = o[c * 8 + 2 * e] * corr + pe * bf2f(w[e] & 0xffffu); o[c * 8 + 2 * e + 1] = o[c * 8 + 2 * e + 1] * corr + pe * bf2f(w[e] >> 16); } }
        }
        const float rl = 1.f / l;
#pragma unroll
        for (int c = 0; c < 8; ++c) { u32x4 w;
#pragma unroll
            for (int e = 0; e < 4; ++e) w[e] = pk2(o[c * 8 + 2 * e] * rl, o[c * 8 + 2 * e + 1] * rl);
            *(u32x4*)(obase + rowq * opitch + c * 8) = w; }
    }
}

__device__ void ph_combine(const P& p, int bid, int nb) {
    const int tid = threadIdx.x, lane = tid & 63, wave = tid >> 6;
    const int gw = bid * NWAVE + wave, ngw = nb * NWAVE;
    const float lam = __expf(wave_sum(p.lq1[lane] * p.lk1[lane])) - __expf(wave_sum(p.lq2[lane] * p.lk2[lane])) + LAMBDA_INIT;
    const bf16* OATT = (const bf16*)(p.ws + WS_OATT); bf16* MIXED = (bf16*)(p.ws + WS_MIXED);
    const float g0 = p.g_subln[2 * lane], g1 = p.g_subln[2 * lane + 1];
    for (int m = gw; m < M; m += ngw) {
#pragma unroll
        for (int h = 0; h < 4; ++h) {
            const unsigned a = *(const unsigned*)(OATT + (size_t)m * D + h * 128 + 2 * lane), c = *(const unsigned*)(OATT + (size_t)m * D + 512 + h * 128 + 2 * lane);
            const float d0 = bf2f(a & 0xffffu) - lam * bf2f(c & 0xffffu), d1 = bf2f(a >> 16) - lam * bf2f(c >> 16);
            const float rstd = 1.0f / sqrtf(wave_sum(d0 * d0 + d1 * d1) * (1.f / 128.f) + EPS);
            *(unsigned*)(MIXED + (size_t)m * D + h * 128 + 2 * lane) = pk2(d0 * rstd * g0 * (1.f - LAMBDA_INIT), d1 * rstd * g1 * (1.f - LAMBDA_INIT));
        }
    }
}

__device__ void ph_outproj(const P& p, SgLds& L, int bid, int nb) {
    const bf16* MIXED = (const bf16*)(p.ws + WS_MIXED); float* H1 = (float*)(p.ws + WS_H1);
    constexpr int T = (M / 128) * (D / 128);
    for (int t = bid; t < T; t += nb) {
        const int tm = t / (D / 128), tn = t % (D / 128), row0 = tm * 128, col0 = tn * 128;
        sgemm_tile<false>(L, [&](int r) -> const void* { return MIXED + (size_t)(row0 + r) * D; }, D, p.w_out, D, [&](int c) { return col0 + c; },
            [&](f32x4 (&acc)[2][4], int wr, int wc, int fr, int fq) {
#pragma unroll
                for (int m = 0; m < 2; ++m)
#pragma unroll
                    for (int n = 0; n < 4; ++n)
#pragma unroll
                        for (int j = 0; j < 4; ++j) { const size_t idx = (size_t)(row0 + wr * 32 + m * 16 + fq * 4 + j) * D + col0 + wc * 64 + n * 16 + fr; H1[idx] = p.x[idx] + acc[m][n][j]; }
            });
    }
}

__device__ void ph_route(const P& p, int bid, int nb) {
    const int tid = threadIdx.x, lane = tid & 63, wave = tid >> 6;
    const int gw = bid * NWAVE + wave, ngw = nb * NWAVE;
    const float* H1 = (const float*)(p.ws + WS_H1); bf16* XN = (bf16*)(p.ws + WS_XN);
    unsigned* CNT = (unsigned*)(p.ws + WS_CTL); int* LIST = (int*)(p.ws + WS_LIST); float* GATE = (float*)(p.ws + WS_GATE);
    for (int m = gw; m < M; m += ngw) {
        const f32x4* xr = (const f32x4*)(H1 + (size_t)m * D) + lane;
        f32x4 v[4]; float ss = 0.f;
#pragma unroll
        for (int j = 0; j < 4; ++j) { v[j] = xr[64 * j]; ss += (v[j].x * v[j].x + v[j].y * v[j].y) + (v[j].z * v[j].z + v[j].w * v[j].w); }
        const float rstd = 1.0f / sqrtf(wave_sum(ss) * (1.f / D) + EPS);
        float lg[32];
#pragma unroll
        for (int e = 0; e < 32; ++e) lg[e] = 0.f;
#pragma unroll
        for (int j = 0; j < 4; ++j) {
            const f32x4 g = ((const f32x4*)p.g_moe)[lane + 64 * j];
            v[j] = v[j] * rstd * g;
            const int k = 4 * lane + 256 * j;
#pragma unroll
            for (int e4 = 0; e4 < 4; ++e4) {
                const f32x4* wr_ = (const f32x4*)(p.w_router + (size_t)(k + e4) * NE);
                const float y = v[j][e4];
#pragma unroll
                for (int q = 0; q < 8; ++q) { const f32x4 w = wr_[q]; lg[4 * q] += y * w.x; lg[4 * q + 1] += y * w.y; lg[4 * q + 2] += y * w.z; lg[4 * q + 3] += y * w.w; }
            }
            u32x2 o; o.x = pk2(v[j].x, v[j].y); o.y = pk2(v[j].z, v[j].w);
            *((u32x2*)(XN + (size_t)m * D) + lane + 64 * j) = o;
        }
#pragma unroll
        for (int e = 0; e < 32; ++e) lg[e] = wave_sum(lg[e]) + p.b_router[e];
        int idx[4]; float val[4];
#pragma unroll
        for (int k = 0; k < 4; ++k) {
            float best = -INFINITY; int bi = 0;
#pragma unroll
            for (int e = 0; e < 32; ++e) { const bool take = lg[e] > best; best = take ? lg[e] : best; bi = take ? e : bi; }
            idx[k] = bi; val[k] = best;
#pragma unroll
            for (int e = 0; e < 32; ++e) lg[e] = (e == bi) ? -INFINITY : lg[e];
        }
        const float e1 = __expf(val[1] - val[0]), e2 = __expf(val[2] - val[0]), e3 = __expf(val[3] - val[0]);
        const float rs = 1.f / (1.f + e1 + e2 + e3);
        if (lane < 4) {
            const int e = lane == 0 ? idx[0] : lane == 1 ? idx[1] : lane == 2 ? idx[2] : idx[3];
            const float gt = (lane == 0 ? 1.f : lane == 1 ? e1 : lane == 2 ? e2 : e3) * rs;
            const unsigned pos = atomicAdd(&CNT[e], 1u);
            LIST[e * M + pos] = m * 4 + lane;
            GATE[(size_t)m * 4 + lane] = gt;
        }
    }
}

struct MoeSched { int cnt[NE]; };
__device__ __forceinline__ bool moe_tile(const unsigned* CNT, int t, int ntn, int& e, int& mt, int& tn, int& rowbase, int& cnt_e) {
    int base = 0, acc = 0;
    for (int i = 0; i < NE; ++i) {
        const int c = (int)CNT[i], tiles = (c + 127) >> 7;
        if (t < acc + tiles * ntn) { e = i; const int u = t - acc; mt = u / ntn; tn = u % ntn; rowbase = base; cnt_e = c; return true; }
        acc += tiles * ntn; base += tiles * 128;
    }
    return false;
}
__device__ void ph_moe1(const P& p, SgLds& L, int bid, int nb) {
    const unsigned* CNT = (const unsigned*)(p.ws + WS_CTL); const int* LIST = (const int*)(p.ws + WS_LIST);
    const bf16* XN = (const bf16*)(p.ws + WS_XN); bf16* ACT = (bf16*)(p.ws + WS_ACT);
    for (int t = bid;; t += nb) {
        int e, mt, tn, rowbase, cnt_e;
        if (!moe_tile(CNT, t, 16, e, mt, tn, rowbase, cnt_e)) break;
        const float* W = p.w_e1 + (size_t)e * D * 2 * DE; const float* B1 = p.b_e1 + (size_t)e * 2 * DE;
        sgemm_tile<false>(L, [&](int r) -> const void* { const int rr = mt * 128 + r; return rr < cnt_e ? (const void*)(XN + (size_t)(LIST[e * M + rr] >> 2) * D) : nullptr; }, D, W, 2 * DE,
            [&](int c) { const int wc = c >> 6, n = (c >> 4) & 3, i = c & 15; return 2 * (tn * 64 + wc * 32 + (n & 1) * 16 + i) + (n >> 1); },
            [&](f32x4 (&acc)[2][4], int wr, int wc, int fr, int fq) {
#pragma unroll
                for (int m = 0; m < 2; ++m)
#pragma unroll
                    for (int n = 0; n < 2; ++n) {
                        const int ac = tn * 64 + wc * 32 + n * 16 + fr; const float bg = B1[2 * ac], bl = B1[2 * ac + 1];
#pragma unroll
                        for (int j = 0; j < 4; ++j) {
                            const int row = rowbase + mt * 128 + wr * 32 + m * 16 + fq * 4 + j;
                            const float glu = fminf(acc[m][n][j] + bg, 7.0f), lin = fminf(fmaxf(acc[m][n + 2][j] + bl, -7.0f), 7.0f);
                            ACT[(size_t)row * DE + ac] = (bf16)f2bf(glu * sigmoidf_(1.702f * glu) * (lin + 1.0f));
                        }
                    }
            });
    }
}
__device__ void ph_moe2(const P& p, SgLds& L, int bid, int nb) {
    const unsigned* CNT = (const unsigned*)(p.ws + WS_CTL); const int* LIST = (const int*)(p.ws + WS_LIST);
    const bf16* ACT = (const bf16*)(p.ws + WS_ACT); bf16* Y = (bf16*)(p.ws + WS_Y);
    for (int t = bid;; t += nb) {
        int e, mt, tn, rowbase, cnt_e;
        if (!moe_tile(CNT, t, 8, e, mt, tn, rowbase, cnt_e)) break;
        const float* W = p.w_e2 + (size_t)e * DE * D; const float* B2 = p.b_e2 + (size_t)e * D;
        const int col0 = tn * 128;
        sgemm_tile<false>(L, [&](int r) -> const void* { return ACT + (size_t)(rowbase + mt * 128 + r) * DE; }, DE, W, D, [&](int c) { return col0 + c; },
            [&](f32x4 (&acc)[2][4], int wr, int wc, int fr, int fq) {
#pragma unroll
                for (int m = 0; m < 2; ++m)
#pragma unroll
                    for (int j = 0; j < 4; ++j) {
                        const int rr = mt * 128 + wr * 32 + m * 16 + fq * 4 + j;
                        if (rr < cnt_e) { const int slot = LIST[e * M + rr];
#pragma unroll
                            for (int n = 0; n < 4; ++n) { const int col = col0 + wc * 64 + n * 16 + fr; Y[(size_t)slot * D + col] = (bf16)f2bf(acc[m][n][j] + B2[col]); } }
                    }
            });
    }
}

__device__ void ph_combine2(const P& p, int bid, int nb) {
    const int tid = threadIdx.x, lane = tid & 63, wave = tid >> 6;
    const int gw = bid * NWAVE + wave, ngw = nb * NWAVE;
    const float* H1 = (const float*)(p.ws + WS_H1); float* H2 = (float*)(p.ws + WS_H2); bf16* XN = (bf16*)(p.ws + WS_XN);
    const bf16* Y = (const bf16*)(p.ws + WS_Y); const float* GATE = (const float*)(p.ws + WS_GATE);
    for (int m = gw; m < M; m += ngw) {
        const f32x4 gt = *(const f32x4*)(GATE + (size_t)m * 4);
        f32x4 v[4]; float ss = 0.f;
#pragma unroll
        for (int j = 0; j < 4; ++j) {
            v[j] = ((const f32x4*)(H1 + (size_t)m * D))[lane + 64 * j];
#pragma unroll
            for (int k = 0; k < 4; ++k) {
                const u32x2 w = *((const u32x2*)(Y + (size_t)(m * 4 + k) * D) + lane + 64 * j);
                const float g = gt[k];
                v[j].x += g * bf2f(w.x & 0xffffu); v[j].y += g * bf2f(w.x >> 16); v[j].z += g * bf2f(w.y & 0xffffu); v[j].w += g * bf2f(w.y >> 16);
            }
            ((f32x4*)(H2 + (size_t)m * D))[lane + 64 * j] = v[j];
            ss += (v[j].x * v[j].x + v[j].y * v[j].y) + (v[j].z * v[j].z + v[j].w * v[j].w);
        }
        const float rstd = 1.0f / sqrtf(wave_sum(ss) * (1.f / D) + EPS);
#pragma unroll
        for (int j = 0; j < 4; ++j) {
            const f32x4 g = ((const f32x4*)p.g_ple)[lane + 64 * j];
            const f32x4 y = v[j] * rstd * g;
            u32x2 o; o.x = pk2(y.x, y.y); o.y = pk2(y.z, y.w);
            *((u32x2*)(XN + (size_t)m * D) + lane + 64 * j) = o;
        }
    }
}

__device__ void ph_gate(const P& p, SgLds& L, int bid, int nb) {
    const bf16* XN = (const bf16*)(p.ws + WS_XN); const float* H2 = (const float*)(p.ws + WS_H2); const bf16* PP = (const bf16*)(p.ws + WS_PP);
    constexpr int T = (M / 128) * (D / 128);
    for (int t = bid; t < T; t += nb) {
        const int tm = t / (D / 128), tn = t % (D / 128), row0 = tm * 128, col0 = tn * 128;
        sgemm_tile<false>(L, [&](int r) -> const void* { return XN + (size_t)(row0 + r) * D; }, D, p.w_gate, D, [&](int c) { return col0 + c; },
            [&](f32x4 (&acc)[2][4], int wr, int wc, int fr, int fq) {
#pragma unroll
                for (int m = 0; m < 2; ++m)
#pragma unroll
                    for (int n = 0; n < 4; ++n)
#pragma unroll
                        for (int j = 0; j < 4; ++j) { const size_t idx = (size_t)(row0 + wr * 32 + m * 16 + fq * 4 + j) * D + col0 + wc * 64 + n * 16 + fr;
                            p.out[idx] = H2[idx] + sigmoidf_(acc[m][n][j]) * bf2f(PP[idx]); }
            });
    }
}

__device__ void ph_final(const P& p, int bid, int nb) {
    const int tid = threadIdx.x, lane = tid & 63, wave = tid >> 6;
    const int gw = bid * NWAVE + wave, ngw = nb * NWAVE;
    for (int m = gw; m < M; m += ngw) {
        f32x4* xr = (f32x4*)(p.out + (size_t)m * D) + lane;
        f32x4 v[4]; float ss = 0.f;
#pragma unroll
        for (int j = 0; j < 4; ++j) { v[j] = xr[64 * j]; ss += (v[j].x * v[j].x + v[j].y * v[j].y) + (v[j].z * v[j].z + v[j].w * v[j].w); }
        const float rstd = 1.0f / sqrtf(wave_sum(ss) * (1.f / D) + EPS);
#pragma unroll
        for (int j = 0; j < 4; ++j) xr[64 * j] = v[j] * rstd * ((const f32x4*)p.g_final)[lane + 64 * j];
    }
}

constexpr int NPHASE = 11;
__device__ __forceinline__ void run_phase(const P& p, SgLds& L, int ph, int bid, int nb) {
    switch (ph) {
        case 0: ph_prologue(p, bid, nb); break;
        case 1: ph_inproj(p, L, bid, nb); break;
        case 2: ph_attn(p, bid, nb); break;
        case 3: ph_combine(p, bid, nb); break;
        case 4: ph_outproj(p, L, bid, nb); break;
        case 5: ph_route(p, bid, nb); break;
        case 6: ph_moe1(p, L, bid, nb); break;
        case 7: ph_moe2(p, L, bid, nb); break;
        case 8: ph_combine2(p, bid, nb); break;
        case 9: ph_gate(p, L, bid, nb); break;
        default: ph_final(p, bid, nb); break;
    }
}

__global__ void __launch_bounds__(NT) k_mega(P p) {
    __shared__ SgLds L;
    cg::grid_group grid = cg::this_grid();
    const int bid = blockIdx.x, nb = gridDim.x;
    ph_prologue(p, bid, nb); grid.sync();
    ph_inproj(p, L, bid, nb); grid.sync();
    ph_attn(p, bid, nb); grid.sync();
    ph_combine(p, bid, nb); grid.sync();
    ph_outproj(p, L, bid, nb); grid.sync();
    ph_route(p, bid, nb); grid.sync();
    ph_moe1(p, L, bid, nb); grid.sync();
    ph_moe2(p, L, bid, nb); grid.sync();
    ph_combine2(p, bid, nb); grid.sync();
    ph_gate(p, L, bid, nb); grid.sync();
    ph_final(p, bid, nb);
}

extern "C" void kernel_launch(void* const* d_in, const int* in_sizes, int n_in, void* d_out, int out_size, void* d_ws, size_t ws_size, hipStream_t stream) {
    if (n_in != 23 || in_sizes[0] != M * D || out_size != M * D || ws_size < WS_END) {
        fprintf(stderr, "kernel_launch: unexpected shapes (n_in %d in0 %d out %d ws %zu)\n", n_in, n_in > 0 ? in_sizes[0] : -1, out_size, ws_size); return; }
    static int grid_blocks = 0;
    if (!grid_blocks) {
        int dev = 0, cus = 0, per_cu = 0;
        hipGetDevice(&dev);
        hipDeviceGetAttribute(&cus, hipDeviceAttributeMultiprocessorCount, dev);
        hipOccupancyMaxActiveBlocksPerMultiprocessor(&per_cu, k_mega, NT, 0);
        if (per_cu < 1) { fprintf(stderr, "kernel_launch: occupancy query says %d blocks per CU\n", per_cu); per_cu = 1; }
        grid_blocks = cus * per_cu;
    }
    P p{};
    p.x = (const float*)d_in[0]; p.p = (const float*)d_in[1]; p.pos = (const int*)d_in[2]; p.g_attn = (const float*)d_in[3]; p.w_in = (const float*)d_in[4];
    p.lq1 = (const float*)d_in[5]; p.lk1 = (const float*)d_in[6]; p.lq2 = (const float*)d_in[7]; p.lk2 = (const float*)d_in[8]; p.g_subln = (const float*)d_in[9];
    p.b_forget = (const float*)d_in[10]; p.w_out = (const float*)d_in[11]; p.g_moe = (const float*)d_in[12]; p.w_router = (const float*)d_in[13]; p.b_router = (const float*)d_in[14];
    p.w_e1 = (const float*)d_in[15]; p.b_e1 = (const float*)d_in[16]; p.w_e2 = (const float*)d_in[17]; p.b_e2 = (const float*)d_in[18];
    p.g_ple = (const float*)d_in[19]; p.w_gate = (const float*)d_in[20]; p.w_proj = (const float*)d_in[21]; p.g_final = (const float*)d_in[22];
    p.out = (float*)d_out; p.ws = (unsigned char*)d_ws;
    void* args[] = {&p};
    hipError_t e = hipLaunchCooperativeKernel((void*)k_mega, dim3(grid_blocks), dim3(NT), args, 0, stream);
    if (e != hipSuccess) fprintf(stderr, "cooperative launch failed: %s (grid %d)\n", hipGetErrorString(e), grid_blocks);
}
```

```cpp
#include <hip/hip_runtime.h>
#include <hip/hip_cooperative_groups.h>
#include <hip/hip_bf16.h>
#include <cstdio>
#include <cstdint>
namespace cg = cooperative_groups;

constexpr int NB = 8, SEQ = 2048, D = 1024, M = NB * SEQ;
constexpr int INW = 3080, NPROJ = 3072;
constexpr int NE = 32, TOPK = 4, DE = 1024, PLE = 256;
constexpr float EPS = 1e-5f;
constexpr float LOG2E = 1.4426950408889634f;
constexpr float QSCALE = 0.125f * LOG2E;
constexpr float LAMBDA_INIT = 0.2f;
constexpr int NT = 512, NWAVE = 8;

typedef unsigned short bf16;
typedef short bf16x8 __attribute__((ext_vector_type(8)));
typedef float f32x4 __attribute__((ext_vector_type(4)));
typedef float f32x2 __attribute__((ext_vector_type(2)));
typedef unsigned u32x4 __attribute__((ext_vector_type(4)));
typedef unsigned u32x2 __attribute__((ext_vector_type(2)));

constexpr size_t MiB = 1u << 20;
constexpr size_t WS_CTL = 0;
constexpr size_t WS_COS = 1 * MiB;
constexpr size_t WS_SIN = WS_COS + 512 * 1024;
constexpr size_t WS_LOGF = 2 * MiB;
constexpr size_t WS_CUM = WS_LOGF + 512 * 1024;
constexpr size_t WS_GATE = 3 * MiB;
constexpr size_t WS_LIST = 4 * MiB;
constexpr size_t WS_XN = 8 * MiB;
constexpr size_t WS_PROJ = 40 * MiB;
constexpr size_t WS_OATT = 136 * MiB;
constexpr size_t WS_MIXED = 184 * MiB;
constexpr size_t WS_H1 = 216 * MiB;
constexpr size_t WS_PP = 280 * MiB;
constexpr size_t WS_ACT = 312 * MiB;
constexpr size_t WS_Y = 456 * MiB;
constexpr size_t WS_H2 = 584 * MiB;
constexpr size_t WS_WIN_T = 648 * MiB;
constexpr size_t WS_WO_T = 654 * MiB;
constexpr size_t WS_WG_T = 656 * MiB;
constexpr size_t WS_WP_T = 658 * MiB;
constexpr size_t WS_PB = 660 * MiB;
constexpr size_t WS_W1_T = 668 * MiB;
constexpr size_t WS_W2_T = 796 * MiB;
constexpr size_t WS_END = 860 * MiB;

constexpr int RING_BYTES = 131072;
constexpr int LDS_TAB = RING_BYTES;
constexpr int LDS_ROWMAP = RING_BYTES + 1024;
constexpr int LDS_BYTES = 147456;

struct P {
    const float* x; const float* p; const int* pos; const float* g_attn; const float* w_in;
    const float* lq1; const float* lk1; const float* lq2; const float* lk2; const float* g_subln; const float* b_forget;
    const float* w_out; const float* g_moe; const float* w_router; const float* b_router;
    const float* w_e1; const float* b_e1; const float* w_e2; const float* b_e2;
    const float* g_ple; const float* w_gate; const float* w_proj; const float* g_final;
    float* out; unsigned char* ws;
};

__device__ __forceinline__ unsigned f2bf(float f) { unsigned u = __builtin_bit_cast(unsigned, f); return (u + 0x7fffu + ((u >> 16) & 1u)) >> 16; }
__device__ __forceinline__ float bf2f(unsigned h) { return __builtin_bit_cast(float, h << 16); }
__device__ __forceinline__ unsigned pk2(float lo, float hi) { return f2bf(lo) | (f2bf(hi) << 16); }
__device__ __forceinline__ float wave_sum(float v) {
#pragma unroll
    for (int o = 1; o < 64; o <<= 1) v += __shfl_xor(v, o);
    return v;
}
__device__ __forceinline__ int opaque_tid() { int t = threadIdx.x; asm volatile("" : "+v"(t)); return t; }
__device__ __forceinline__ float sigmoidf_(float z) { return 1.0f / (1.0f + __expf(-z)); }

struct SgLds { bf16 a[128][40]; bf16 b[128][40]; };

template <bool A_F32, class RowPtr, class ColMap, class Epi>
__device__ __forceinline__ void sgemm_tile(SgLds& L, RowPtr rowptr, int K, const float* __restrict__ W, int ldw, ColMap colmap, Epi epi) {
    const int tid = opaque_tid(), lane = tid & 63, wid = tid >> 6, wr = wid >> 1, wc = wid & 1, fr = lane & 15, fq = lane >> 4;
    const int ar = tid >> 2, akc = (tid & 3) * 8;
    const void* aptr = rowptr(ar);
    const int bk = tid >> 4, bnc = (tid & 15) * 8;
    int wcol[8];
#pragma unroll
    for (int i = 0; i < 8; ++i) wcol[i] = colmap(bnc + i);
    f32x4 acc[2][4];
#pragma unroll
    for (int m = 0; m < 2; ++m)
#pragma unroll
        for (int n = 0; n < 4; ++n) acc[m][n] = (f32x4){0.f, 0.f, 0.f, 0.f};
    for (int k0 = 0; k0 < K; k0 += 32) {
        u32x4 av = (u32x4){0u, 0u, 0u, 0u};
        if (aptr) {
            if (A_F32) { const float* ap = (const float*)aptr + k0 + akc; const f32x4 v0 = *(const f32x4*)ap, v1 = *(const f32x4*)(ap + 4);
                av.x = pk2(v0.x, v0.y); av.y = pk2(v0.z, v0.w); av.z = pk2(v1.x, v1.y); av.w = pk2(v1.z, v1.w); }
            else av = *(const u32x4*)((const bf16*)aptr + k0 + akc);
        }
        float wv[8];
#pragma unroll
        for (int i = 0; i < 8; ++i) wv[i] = W[(size_t)(k0 + bk) * ldw + wcol[i]];
        __syncthreads();
        *(u32x4*)&L.a[ar][akc] = av;
#pragma unroll
        for (int i = 0; i < 8; ++i) L.b[bnc + i][bk] = (bf16)f2bf(wv[i]);
        __syncthreads();
        bf16x8 af[2], bfr[4];
#pragma unroll
        for (int m = 0; m < 2; ++m) af[m] = *(const bf16x8*)&L.a[wr * 32 + m * 16 + fr][fq * 8];
#pragma unroll
        for (int n = 0; n < 4; ++n) bfr[n] = *(const bf16x8*)&L.b[wc * 64 + n * 16 + fr][fq * 8];
#pragma unroll
        for (int m = 0; m < 2; ++m)
#pragma unroll
            for (int n = 0; n < 4; ++n) acc[m][n] = __builtin_amdgcn_mfma_f32_16x16x32_bf16(af[m], bfr[n], acc[m][n], 0, 0, 0);
    }
    epi(acc, wr, wc, fr, fq);
}

namespace pg8 {
#define PG8_LAS __attribute__((address_space(3)))
constexpr int BM = 256, BK = 64, HALF = 128, HTB = HALF * BK * 2  , STAGE_BYTES = 8 * HTB, NXCD = 8, WGM = 8;

__host__ __device__ __forceinline__ int lds_byte(int r, int c) { const int st = (r >> 4) * 2 + (c >> 5), rr = r & 15, cc = c & 31, ob = rr * 64 + cc * 2; return st * 1024 + (ob ^ (((ob >> 9) & 1) << 5)); }
__host__ __device__ __forceinline__ void stage_rc(int b, int& R, int& C) { const int st = b / 1024, sb = b % 1024, swz = sb ^ (((sb >> 9) & 1) << 5); R = (st >> 1) * 16 + swz / 64; C = (st & 1) * 32 + (swz % 64) / 2; }
__host__ __device__ __forceinline__ int perm32(int rho) { const int n = rho >> 4, i = rho & 15; return 8 * (i >> 2) + 4 * n + (i & 3); }

struct Unit { int pm, pn, e, li; };

struct DenseSched {
    int nM, nN, nwg, G, c, K; const char* A; const char* Bt;
    __device__ void init(const void* A_, const void* Bt_, int M_, int N_, int K_, int G_, int c_) { A = (const char*)A_; Bt = (const char*)Bt_; nM = M_ / BM; nN = N_ / BM; nwg = nM * nN; G = G_; c = c_; K = K_; }
    __device__ bool next(int i, Unit& u) const {
        const long L = (long)i * G + c; if (L >= nwg) return false;
        int wgid = (int)L; { const int q = nwg / NXCD, r = nwg % NXCD, xcd = wgid % NXCD, off = wgid / NXCD; wgid = (xcd < r ? xcd * (q + 1) : r * (q + 1) + (xcd - r) * q) + off; }
        const int nig = WGM * nN, gid = wgid / nig, fm = gid * WGM, gsz = (nM - fm) < WGM ? (nM - fm) : WGM;
        u.pm = fm + ((wgid % nig) % gsz); u.pn = (wgid % nig) / gsz; u.e = 0; u.li = i; return true;
    }
    static constexpr bool GATHER = false;
    __device__ __forceinline__ const char* a_base() const { return A; }
    __device__ __forceinline__ unsigned a_row(const Unit& u, int r) const { return (unsigned)(u.pm * BM + r); }
    __device__ __forceinline__ const char* b_ptr(const Unit& u) const { return Bt + (size_t)u.pn * BM * K * 2; }
};

__device__ __forceinline__ unsigned cvt_pk_bf16(float lo, float hi) { unsigned r; asm volatile("v_cvt_pk_bf16_f32 %0, %1, %2" : "=v"(r) : "v"(lo), "v"(hi)); return r; }
__device__ __forceinline__ float sigm(float z) { return __builtin_amdgcn_rcpf(1.0f + __builtin_amdgcn_exp2f(-LOG2E * z)); }

struct EpiBf16 {
    static constexpr bool PERM = true;
    bf16* O; int ldc;
    __device__ __forceinline__ void operator()(const f32x4 (&acc)[2][2][4][2], const Unit& u, int wr, int wc, int fr, int fq) const {
        const int row0 = u.pm * BM + wr * 64 + fr, col0 = u.pn * BM + wc * 32 + 8 * fq;
#pragma unroll
        for (int ai = 0; ai < 2; ++ai)
#pragma unroll
            for (int m = 0; m < 4; ++m) { bf16* rowp = O + (size_t)(row0 + ai * HALF + m * 16) * ldc + col0;
#pragma unroll
                for (int bj = 0; bj < 2; ++bj) { const f32x4 v0 = acc[ai][bj][m][0], v1 = acc[ai][bj][m][1];
                    u32x4 w; w.x = cvt_pk_bf16(v0[0], v0[1]); w.y = cvt_pk_bf16(v0[2], v0[3]); w.z = cvt_pk_bf16(v1[0], v1[1]); w.w = cvt_pk_bf16(v1[2], v1[3]);
                    *(u32x4*)(rowp + bj * HALF) = w; } }
    }
};
struct EpiInproj {
    static constexpr bool PERM = true;
    bf16* O; const float* COS; const float* SIN;
    __device__ __forceinline__ void operator()(const f32x4 (&acc)[2][2][4][2], const Unit& u, int wr, int wc, int fr, int fq) const {
        const int row0 = u.pm * BM + wr * 64 + fr, colt = u.pn * BM, col0 = colt + wc * 32 + 8 * fq;
        const bool rope = (colt < 1024) && ((wc & 1) == 0);
        const float sc = (colt < 512 || (colt >= 1536 && colt < 2048)) ? QSCALE : 1.0f;
#pragma unroll
        for (int ai = 0; ai < 2; ++ai)
#pragma unroll
            for (int m = 0; m < 4; ++m) {
                const int row = row0 + ai * HALF + m * 16; bf16* rowp = O + (size_t)row * NPROJ + col0;
#pragma unroll
                for (int bj = 0; bj < 2; ++bj) { f32x4 v[2] = {acc[ai][bj][m][0], acc[ai][bj][m][1]};
                    if (rope) {
#pragma unroll
                        for (int n = 0; n < 2; ++n) { const f32x4 c = *(const f32x4*)(COS + (size_t)row * 8 + 4 * n), s = *(const f32x4*)(SIN + (size_t)row * 8 + 4 * n); f32x4 pr;
#pragma unroll
                            for (int i = 0; i < 4; ++i) pr[i] = __shfl_xor(v[n][i], 16);
                            const f32x4 lo = v[n] * c - pr * s, hi = v[n] * c + pr * s;
                            v[n] = (fq == 0) ? lo : (fq == 1) ? hi : v[n]; } }
                    v[0] = v[0] * sc; v[1] = v[1] * sc;
                    u32x4 w; w.x = cvt_pk_bf16(v[0][0], v[0][1]); w.y = cvt_pk_bf16(v[0][2], v[0][3]); w.z = cvt_pk_bf16(v[1][0], v[1][1]); w.w = cvt_pk_bf16(v[1][2], v[1][3]);
                    *(u32x4*)(rowp + bj * HALF) = w; } }
    }
};
struct EpiResF32 {
    static constexpr bool PERM = false;
    const float* base; float* C; int ldc;
    __device__ __forceinline__ void operator()(const f32x4 (&acc)[2][2][4][2], const Unit& u, int wr, int wc, int fr, int fq) const {
        const int row0 = u.pm * BM + wr * 64 + fr, col0 = u.pn * BM + wc * 32 + 4 * fq;
#pragma unroll
        for (int ai = 0; ai < 2; ++ai)
#pragma unroll
            for (int m = 0; m < 4; ++m) { const size_t off = (size_t)(row0 + ai * HALF + m * 16) * ldc + col0;
#pragma unroll
                for (int bj = 0; bj < 2; ++bj)
#pragma unroll
                    for (int n = 0; n < 2; ++n) *(f32x4*)(C + off + bj * HALF + n * 16) = *(const f32x4*)(base + off + bj * HALF + n * 16) + acc[ai][bj][m][n]; }
    }
};
struct EpiGate {
    static constexpr bool PERM = false;
    const float* H2; const bf16* PP; float* C; int ldc;
    __device__ __forceinline__ void operator()(const f32x4 (&acc)[2][2][4][2], const Unit& u, int wr, int wc, int fr, int fq) const {
        const int row0 = u.pm * BM + wr * 64 + fr, col0 = u.pn * BM + wc * 32 + 4 * fq;
#pragma unroll
        for (int ai = 0; ai < 2; ++ai)
#pragma unroll
            for (int m = 0; m < 4; ++m) { const size_t off = (size_t)(row0 + ai * HALF + m * 16) * ldc + col0;
#pragma unroll
                for (int bj = 0; bj < 2; ++bj)
#pragma unroll
                    for (int n = 0; n < 2; ++n) { const size_t o = off + bj * HALF + n * 16; const u32x2 pw = *(const u32x2*)(PP + o); const f32x4 a = acc[ai][bj][m][n];
                        f32x4 r = *(const f32x4*)(H2 + o);
                        r[0] += sigm(a[0]) * __builtin_bit_cast(float, pw.x << 16); r[1] += sigm(a[1]) * __builtin_bit_cast(float, pw.x & 0xffff0000u);
                        r[2] += sigm(a[2]) * __builtin_bit_cast(float, pw.y << 16); r[3] += sigm(a[3]) * __builtin_bit_cast(float, pw.y & 0xffff0000u);
                        *(f32x4*)(C + o) = r; } }
    }
};

struct MoeTab { int tstart[33]; int rbase[32]; int cnt[32]; int mt[32]; };
static_assert(sizeof(MoeTab) <= 1024, "MoeTab must fit below the row maps");
template <int MODE  > struct MoeSched {
    static constexpr bool GATHER = (MODE == 1);
    const PG8_LAS MoeTab* T; const PG8_LAS int* rowmap; int nN, G, c, K; const char* A; const char* Bt; size_t bstride;
    __device__ bool next(int i, Unit& u) const {
        const int nwg = __builtin_amdgcn_readfirstlane(T->tstart[32]); const long L = (long)i * G + c; if (L >= nwg) return false;
        int wgid = (int)L; { const int q = nwg / NXCD, r = nwg % NXCD, xcd = wgid % NXCD, off = wgid / NXCD; wgid = (xcd < r ? xcd * (q + 1) : r * (q + 1) + (xcd - r) * q) + off; }
        int e = 0;
        for (int j = 1; j < 32; ++j) e = (wgid >= T->tstart[j]) ? j : e;
        e = __builtin_amdgcn_readfirstlane(e);
        const int r = wgid - __builtin_amdgcn_readfirstlane(T->tstart[e]), mt = __builtin_amdgcn_readfirstlane(T->mt[e]);
        u.e = e; u.pm = r % mt; u.pn = r / mt; u.li = i; return true;
    }
    __device__ __forceinline__ const char* a_base() const { return A; }
    __device__ __forceinline__ unsigned a_row(const Unit& u, int r) const { return MODE == 1 ? (unsigned)rowmap[u.li * 256 + r] : (unsigned)(__builtin_amdgcn_readfirstlane(T->rbase[u.e]) + u.pm * BM + r); }
    __device__ __forceinline__ const char* b_ptr(const Unit& u) const { return Bt + (size_t)u.e * bstride + (size_t)u.pn * BM * K * 2; }
};
__device__ __forceinline__ float swiglu(float g, float l) { const float glu = fminf(g, 7.0f), lin = fminf(fmaxf(l, -7.0f), 7.0f); return glu * sigm(1.702f * glu) * (lin + 1.0f); }
struct EpiMoe1 {
    static constexpr bool PERM = true;
    bf16* ACT; const float* B1; const PG8_LAS MoeTab* T;
    __device__ __forceinline__ void operator()(const f32x4 (&acc)[2][2][4][2], const Unit& u, int wr, int wc, int fr, int fq) const {
        const int row0 = T->rbase[u.e] + u.pm * BM + wr * 64 + fr, acol0 = u.pn * 128 + wc * 16 + 4 * fq;
        const float* bp = B1 + (size_t)u.e * 2 * DE + u.pn * BM + wc * 32 + 8 * fq;
        f32x4 bv[2][2];
#pragma unroll
        for (int bj = 0; bj < 2; ++bj)
#pragma unroll
            for (int n = 0; n < 2; ++n) bv[bj][n] = *(const f32x4*)(bp + bj * HALF + 4 * n);
#pragma unroll
        for (int ai = 0; ai < 2; ++ai)
#pragma unroll
            for (int m = 0; m < 4; ++m) { bf16* rowp = ACT + (size_t)(row0 + ai * HALF + m * 16) * DE + acol0;
#pragma unroll
                for (int bj = 0; bj < 2; ++bj) { const f32x4 v0 = acc[ai][bj][m][0] + bv[bj][0], v1 = acc[ai][bj][m][1] + bv[bj][1];
                    u32x2 w; w.x = cvt_pk_bf16(swiglu(v0[0], v0[1]), swiglu(v0[2], v0[3])); w.y = cvt_pk_bf16(swiglu(v1[0], v1[1]), swiglu(v1[2], v1[3]));
                    *(u32x2*)(rowp + bj * 64) = w; } }
    }
};
struct EpiMoe2 {
    static constexpr bool PERM = true;
    bf16* Y; const float* B2; const PG8_LAS int* rowmap;
    __device__ __forceinline__ void operator()(const f32x4 (&acc)[2][2][4][2], const Unit& u, int wr, int wc, int fr, int fq) const {
        const int col0 = u.pn * BM + wc * 32 + 8 * fq;
        const float* bp = B2 + (size_t)u.e * D + col0;
        f32x4 bv[2][2];
#pragma unroll
        for (int bj = 0; bj < 2; ++bj)
#pragma unroll
            for (int n = 0; n < 2; ++n) bv[bj][n] = *(const f32x4*)(bp + bj * HALF + 4 * n);
#pragma unroll
        for (int ai = 0; ai < 2; ++ai)
#pragma unroll
            for (int m = 0; m < 4; ++m) { const int slot = rowmap[u.li * 256 + ai * HALF + wr * 64 + m * 16 + fr];
                if (slot >= 0) { bf16* rowp = Y + (size_t)slot * D + col0;
#pragma unroll
                    for (int bj = 0; bj < 2; ++bj) { const f32x4 v0 = acc[ai][bj][m][0] + bv[bj][0], v1 = acc[ai][bj][m][1] + bv[bj][1];
                        u32x4 w; w.x = cvt_pk_bf16(v0[0], v0[1]); w.y = cvt_pk_bf16(v0[2], v0[3]); w.z = cvt_pk_bf16(v1[0], v1[1]); w.w = cvt_pk_bf16(v1[2], v1[3]);
                        *(u32x4*)(rowp + bj * HALF) = w; } } }
    }
};

template <class Epi, class Sched, bool ALIGN_EPI>
__device__ __forceinline__ void gemm_phase(PG8_LAS unsigned char* lds, const int K, const Sched& S, const Epi& E) {
    constexpr bool GA = Sched::GATHER;
    int tid_ = opaque_tid();
    const int tid = tid_, wid = __builtin_amdgcn_readfirstlane(tid >> 6), lane = tid & 63, wr = wid >> 2, wc = wid & 3, fr = lane & 15, fq = lane >> 4;
    const int nt = K / BK;
    unsigned voffA[2], voffB[2];
#pragma unroll
    for (int i = 0; i < 2; ++i) { int R, C; stage_rc(tid * 16 + i * 8192, R, C); const int Rb = Epi::PERM ? ((R & ~31) + perm32(R & 31)) : R;
        voffA[i] = (unsigned)(R * K + C) * 2u; voffB[i] = (unsigned)(Rb * K + C) * 2u; }
    const size_t kstep = (size_t)(BK * 2);
    const size_t hstep = (size_t)HALF * K * 2;
    const unsigned ldsw = (unsigned)wid * 1024u;
    const int aoff = lds_byte(wr * 64 + fr, fq * 8), boff = lds_byte(wc * 32 + fr, fq * 8);
    const char* const Ab = S.a_base();
#define PG8_SA(b, h) (((b) * 2 + (h)) * HTB)
#define PG8_SB(b, h) ((4 + (b) * 2 + (h)) * HTB)
#define PG8_STAGE(bufoff, gbase, voff) do { _Pragma("unroll") for (int _i = 0; _i < 2; ++_i) \
        __builtin_amdgcn_global_load_lds((const unsigned*)((const char*)(gbase) + (voff)[_i]), (PG8_LAS unsigned*)(lds + (bufoff) + ldsw + _i * 8192), 16, 0, 0); } while (0)
#define PG8_STAGE_A(bufoff, up, vp, h, ko) do { if constexpr (GA) PG8_STAGE(bufoff, Ab + (ko), (vp)[h]); else PG8_STAGE(bufoff, (up) + (h) * hstep + (ko), voffA); } while (0)
#define PG8_LDA(dst, b, h) do { _Pragma("unroll") for (int m = 0; m < 4; ++m) _Pragma("unroll") for (int k = 0; k < 2; ++k) dst[m][k] = *(const PG8_LAS bf16x8*)(lds + PG8_SA(b, h) + aoff + m * 2048 + k * 1024); } while (0)
#define PG8_LDB(dst, b, h) do { _Pragma("unroll") for (int n = 0; n < 2; ++n) _Pragma("unroll") for (int k = 0; k < 2; ++k) dst[n][k] = *(const PG8_LAS bf16x8*)(lds + PG8_SB(b, h) + boff + n * 2048 + k * 1024); } while (0)
#define PG8_MMA(ai, bj, At, Bt) do { __builtin_amdgcn_s_setprio(1); _Pragma("unroll") for (int m = 0; m < 4; ++m) _Pragma("unroll") for (int n = 0; n < 2; ++n) _Pragma("unroll") for (int k = 0; k < 2; ++k) \
        acc[ai][bj][m][n] = __builtin_amdgcn_mfma_f32_16x16x32_bf16(Bt[n][k], At[m][k], acc[ai][bj][m][n], 0, 0, 0); __builtin_amdgcn_s_setprio(0); } while (0)
#define PG8_WAIT_V(n) asm volatile("s_waitcnt vmcnt(" #n ")" ::: "memory")
#define PG8_WAIT_L(n) asm volatile("s_waitcnt lgkmcnt(" #n ")" ::: "memory")
#define PG8_BAR __builtin_amdgcn_s_barrier()
#define PG8_SCHED __builtin_amdgcn_sched_barrier(0)
#define PG8_AOFF(dst, u) do { if constexpr (GA) { _Pragma("unroll") for (int _h = 0; _h < 2; ++_h) _Pragma("unroll") for (int _i = 0; _i < 2; ++_i) { int R_, C_; stage_rc(tid * 16 + _i * 8192, R_, C_); \
        dst[_h][_i] = S.a_row(u, _h * HALF + R_) * (unsigned)(K * 2) + (unsigned)C_ * 2u; } } } while (0)
    Unit cur, nxt; int ui = 0;
    if (!S.next(0, cur)) return;
    f32x4 acc[2][2][4][2];
#pragma unroll
    for (int a = 0; a < 2; ++a)
#pragma unroll
        for (int b = 0; b < 2; ++b)
#pragma unroll
            for (int m = 0; m < 4; ++m)
#pragma unroll
                for (int n = 0; n < 2; ++n) acc[a][b][m][n] = (f32x4){0.f, 0.f, 0.f, 0.f};
    bf16x8 At[4][2], B0[2][2], B1[2][2];
    unsigned vAc[2][2];
    PG8_AOFF(vAc, cur);
    const char* cA = GA ? Ab : Ab + (size_t)S.a_row(cur, 0) * K * 2;
    const char* cB = S.b_ptr(cur);
    PG8_STAGE(PG8_SB(0, 0), cB, voffB); PG8_STAGE(PG8_SB(0, 1), cB + hstep, voffB); PG8_STAGE_A(PG8_SA(0, 0), cA, vAc, 0, 0); PG8_STAGE_A(PG8_SA(0, 1), cA, vAc, 1, 0);
    if (wr == 1) PG8_BAR;
    PG8_WAIT_V(2); PG8_BAR;
    PG8_STAGE(PG8_SB(1, 0), cB + kstep, voffB); PG8_STAGE_A(PG8_SA(1, 0), cA, vAc, 0, kstep); PG8_STAGE(PG8_SB(1, 1), cB + hstep + kstep, voffB);
    PG8_WAIT_V(6); PG8_BAR;
    for (;;) {
        const bool has_next = S.next(ui + 1, nxt);
        const char* nB = cB; const char* nA = cA;
        if (has_next) { nB = S.b_ptr(nxt); if constexpr (!GA) nA = Ab + (size_t)S.a_row(nxt, 0) * K * 2; }
        for (int t = 0; t < nt; t += 2) {
            const bool last = (t == nt - 2);
            const size_t k1 = (size_t)(t + 1) * kstep, k2 = last ? 0 : (size_t)(t + 2) * kstep, k3 = k2 + kstep;
            const char* a2 = last ? nA : cA; const char* b2 = last ? nB : cB + (size_t)(t + 2) * kstep; const char* b3 = b2 + kstep;
            unsigned v2[2][2];
            if constexpr (GA) {
                if (last && has_next) PG8_AOFF(v2, nxt);
                else {
#pragma unroll
                    for (int h = 0; h < 2; ++h)
#pragma unroll
                        for (int i = 0; i < 2; ++i) v2[h][i] = vAc[h][i];
                }
            }
            PG8_LDB(B0, 0, 0); PG8_LDB(B1, 0, 1); PG8_SCHED; PG8_LDA(At, 0, 0); PG8_STAGE_A(PG8_SA(1, 1), cA, vAc, 1, k1);
            PG8_WAIT_V(8); PG8_WAIT_L(0); PG8_BAR; PG8_MMA(0, 0, At, B0); PG8_MMA(0, 1, At, B1); PG8_BAR; PG8_SCHED;
            PG8_LDA(At, 0, 1); PG8_STAGE(PG8_SB(0, 0), b2, voffB); PG8_STAGE(PG8_SB(0, 1), b2 + hstep, voffB); PG8_STAGE_A(PG8_SA(0, 0), a2, v2, 0, k2);
            PG8_WAIT_V(8); PG8_WAIT_L(0); PG8_BAR; PG8_MMA(1, 0, At, B0); PG8_MMA(1, 1, At, B1); PG8_BAR; PG8_SCHED;
            PG8_LDB(B0, 1, 0); PG8_LDB(B1, 1, 1); PG8_SCHED; PG8_LDA(At, 1, 0); PG8_STAGE_A(PG8_SA(0, 1), a2, v2, 1, k2);
            PG8_WAIT_V(8); PG8_WAIT_L(0); PG8_BAR; PG8_MMA(0, 0, At, B0); PG8_MMA(0, 1, At, B1); PG8_BAR; PG8_SCHED;
            PG8_LDA(At, 1, 1); PG8_STAGE(PG8_SB(1, 0), b3, voffB); PG8_STAGE(PG8_SB(1, 1), b3 + hstep, voffB); PG8_STAGE_A(PG8_SA(1, 0), a2, v2, 0, k3);
            PG8_WAIT_V(8); PG8_WAIT_L(0); PG8_BAR; PG8_MMA(1, 0, At, B0); PG8_MMA(1, 1, At, B1); PG8_BAR; PG8_SCHED;
        }
        if constexpr (ALIGN_EPI) { if (wr == 0) PG8_BAR; }
        E(acc, cur, wr, wc, fr, fq);
        if (!has_next) break;
#pragma unroll
        for (int a = 0; a < 2; ++a)
#pragma unroll
            for (int b = 0; b < 2; ++b)
#pragma unroll
                for (int m = 0; m < 4; ++m)
#pragma unroll
                    for (int n = 0; n < 2; ++n) acc[a][b][m][n] = (f32x4){0.f, 0.f, 0.f, 0.f};
        cur = nxt; cA = nA; cB = nB; ++ui;
        PG8_AOFF(vAc, cur);
        if constexpr (ALIGN_EPI) { if (wr == 1) PG8_BAR; }
    }
    PG8_WAIT_V(0);
    if constexpr (!ALIGN_EPI) { if (wr == 0) PG8_BAR; }
    PG8_BAR;
#undef PG8_SA
#undef PG8_SB
#undef PG8_STAGE
#undef PG8_STAGE_A
#undef PG8_LDA
#undef PG8_LDB
#undef PG8_MMA
#undef PG8_WAIT_V
#undef PG8_WAIT_L
#undef PG8_BAR
#undef PG8_SCHED
#undef PG8_AOFF
}
}

namespace attn_body {
using bf16=__hip_bfloat16;
using bf16x8=__attribute__((ext_vector_type(8)))short;
using s16x4=__attribute__((ext_vector_type(4)))short;
using f32x16=__attribute__((ext_vector_type(16)))float;
using u32x4=__attribute__((ext_vector_type(4)))unsigned;
constexpr int SEQ=2048,D=64,PQ=3072,PO=1024;
constexpr int NW=8,QBLK=32,QB=QBLK*NW,KVBLK=64,NQB=SEQ/QB;
constexpr int ATTN_UNIT_ROWS=QB;
__device__ __forceinline__ int crow(int r,int hi){return (r&3)+8*(r>>2)+4*hi;}
#define SBAR() __builtin_amdgcn_sched_barrier(0)
__device__ __forceinline__ void cmask(f32x16&p0,f32x16&p1,int jb,int qrel,int hi){
  const float NEG=-INFINITY; int kb=64*jb+4*hi;
  #pragma unroll
  for(int r=0;r<16;++r){int kv=kb+(r&3)+8*(r>>2); if(kv>qrel)p0[r]=NEG; if(kv+32>qrel)p1[r]=NEG;}
}

constexpr int NSLOT=3, SLOTB=8192;
constexpr int LDS_K=0, LDS_V=NSLOT*SLOTB, LDS_WS=2*NSLOT*SLOTB, LDS_OST=LDS_WS+NW*64*4, LDS_BIAS=LDS_OST+NW*4096, LDS_BYTES=LDS_BIAS+SEQ*4;
constexpr float C2=0.125f*1.4426950408889634f;
__device__ __forceinline__ void glds16(const void*gsrc,unsigned lds_dst){unsigned keep;
  asm volatile("s_mov_b32 %0, m0\n\ts_mov_b32 m0, %2\n\ts_nop 0\n\tglobal_load_lds_dwordx4 %1, off\n\ts_mov_b32 m0, %0":"=&s"(keep):"v"(gsrc),"s"(lds_dst):"memory");}
__device__ __forceinline__ float max3f(float a,float b,float c){float r;asm("v_max3_f32 %0, %1, %2, %3":"=v"(r):"v"(a),"v"(b),"v"(c));return r;}
__device__ __forceinline__ float max2f(float a,float b){float r;asm("v_max_f32_e32 %0, %1, %2":"=v"(r):"v"(a),"v"(b));return r;}
__device__ __forceinline__ float fadd_s(float a,float b){float r;asm("v_add_f32_e32 %0, %1, %2":"=v"(r):"v"(a),"v"(b));return r;}
__device__ __forceinline__ float fsub_s(float a,float b){float r;asm("v_sub_f32_e32 %0, %1, %2":"=v"(r):"v"(a),"v"(b));return r;}
typedef float f32x4_t __attribute__((ext_vector_type(4))); typedef float f32x2_t __attribute__((ext_vector_type(2))); typedef __bf16 bf16x2_t __attribute__((ext_vector_type(2)));
__device__ __forceinline__ unsigned cvtpk_s(float lo,float hi){f32x2_t v={lo,hi};bf16x2_t b=__builtin_convertvector(v,bf16x2_t);return __builtin_bit_cast(unsigned,b);}
#define WAIT_BAR(N) asm volatile("s_waitcnt vmcnt(" #N ") lgkmcnt(0)\n\ts_barrier":::"memory")

__device__ __forceinline__ void qkt(f32x16&p0,f32x16&p1,const char*Kslot,const bf16x8*qr,const f32x16&negm,int r32,int hi){
  const char*kb=Kslot+hi*1024+r32*16;
  #pragma unroll
  for(int d0=0;d0<4;++d0){
    const bf16x8 b0=*reinterpret_cast<const bf16x8*>(kb+d0*2048);
    const bf16x8 b1=*reinterpret_cast<const bf16x8*>(kb+d0*2048+512);
    if(d0==0){p0=__builtin_amdgcn_mfma_f32_32x32x16_bf16(b0,qr[0],negm,0,0,0);p1=__builtin_amdgcn_mfma_f32_32x32x16_bf16(b1,qr[0],negm,0,0,0);}
    else{p0=__builtin_amdgcn_mfma_f32_32x32x16_bf16(b0,qr[d0],p0,0,0,0);p1=__builtin_amdgcn_mfma_f32_32x32x16_bf16(b1,qr[d0],p1,0,0,0);}}
}
typedef __attribute__((address_space(3))) const char* lds_cptr;
typedef short v4i16_t __attribute__((ext_vector_type(4)));
__device__ __forceinline__ void kload8(bf16x8*kf,lds_cptr kp){
  kf[0]=*(const __attribute__((address_space(3))) bf16x8*)(kp);      kf[1]=*(const __attribute__((address_space(3))) bf16x8*)(kp+512);
  kf[2]=*(const __attribute__((address_space(3))) bf16x8*)(kp+2048); kf[3]=*(const __attribute__((address_space(3))) bf16x8*)(kp+2560);
  kf[4]=*(const __attribute__((address_space(3))) bf16x8*)(kp+4096); kf[5]=*(const __attribute__((address_space(3))) bf16x8*)(kp+4608);
  kf[6]=*(const __attribute__((address_space(3))) bf16x8*)(kp+6144); kf[7]=*(const __attribute__((address_space(3))) bf16x8*)(kp+6656);
}
__device__ __forceinline__ void kload2(bf16x8*kf,lds_cptr kp,int j){ kf[2*j]=*(const __attribute__((address_space(3))) bf16x8*)(kp+j*2048); kf[2*j+1]=*(const __attribute__((address_space(3))) bf16x8*)(kp+j*2048+512); }
__device__ __forceinline__ s16x4 vtr(lds_cptr p){ return __builtin_bit_cast(s16x4,__builtin_amdgcn_ds_read_tr16_b64_v4i16((__attribute__((address_space(3))) v4i16_t*)p)); }
__device__ __forceinline__ float rowmax(const f32x16&p0,const f32x16&p1){
  float a=max3f(p0[0],p0[1],p1[0]),b=max3f(p0[2],p0[3],p1[1]);a=max3f(a,p1[2],p1[3]);
  #pragma unroll
  for(int r=4;r<16;r+=4){a=max3f(a,p0[r],p0[r+1]);b=max3f(b,p0[r+2],p0[r+3]);a=max3f(a,p1[r],p1[r+1]);b=max3f(b,p1[r+2],p1[r+3]);}
  const float m=max2f(a,b);
  auto rr=__builtin_amdgcn_permlane32_swap(__float_as_uint(m),__float_as_uint(m),false,false);
  return max2f(__uint_as_float(rr[0]),__uint_as_float(rr[1]));
}
__device__ __forceinline__ void pv(f32x16*o,int vb,bf16x8 pa0,bf16x8 pa1,bf16x8 pa2,bf16x8 pa3){
  #pragma unroll
  for(int d0=0;d0<2;++d0){s16x4 lo[4],hi[4];
    #pragma unroll
    for(int ks=0;ks<4;++ks){
      asm volatile("ds_read_b64_tr_b16 %0,%1 offset:%c2":"=&v"(lo[ks]):"v"(vb),"i"(d0*4096+ks*1024):"memory");
      asm volatile("ds_read_b64_tr_b16 %0,%1 offset:%c2":"=&v"(hi[ks]):"v"(vb),"i"(d0*4096+ks*1024+512):"memory");}
    asm volatile("s_waitcnt lgkmcnt(0)":::"memory");SBAR();
    #define PK(k) (bf16x8){lo[k][0],lo[k][1],lo[k][2],lo[k][3],hi[k][0],hi[k][1],hi[k][2],hi[k][3]}
    o[d0]=__builtin_amdgcn_mfma_f32_32x32x16_bf16(pa0,PK(0),o[d0],0,0,0);
    o[d0]=__builtin_amdgcn_mfma_f32_32x32x16_bf16(pa1,PK(1),o[d0],0,0,0);
    o[d0]=__builtin_amdgcn_mfma_f32_32x32x16_bf16(pa2,PK(2),o[d0],0,0,0);
    o[d0]=__builtin_amdgcn_mfma_f32_32x32x16_bf16(pa3,PK(3),o[d0],0,0,0);
    #undef PK
  }
}

#ifndef ATTN_STORE16
#define ATTN_STORE16(p,v) (*(u32x4*)(p)=(v))
#endif
template<int THRL,bool FOX> __device__ __forceinline__ void attn_unit(int b,int qb,int qcol,int kcol,int vcol,int ocol,const bf16*Q,const bf16*__restrict__ K,const bf16*__restrict__ V,bf16*O,const float*__restrict__ CB,char*shm){
  int tid_=threadIdx.x; asm volatile("":"+v"(tid_));
  const int tid=tid_,lane=tid&63,r32=lane&31,hi=lane>>5; const int wid=__builtin_amdgcn_readfirstlane(tid>>6);
  const long rowbase=(long)b*SEQ; const int q0=qb*QB;
  const bf16*Qw=Q+(rowbase+q0+wid*QBLK)*PQ+qcol;
  const bf16*Kh=K+rowbase*PQ+kcol,*Vh=V+rowbase*PQ+vcol;
  const unsigned lds0=(unsigned)(uintptr_t)shm;
  float*wsf=(float*)(shm+LDS_WS)+wid*64;
  const bf16*ksrc=Kh+(long)lane*PQ+wid*8;
  const bf16*vsrc=Vh+(long)(16*(wid&3)+(lane>>2))*PQ+(wid>>2)*32+(lane&3)*8;
  const unsigned kdst=lds0+LDS_K+wid*1024, vdst=lds0+LDS_V+wid*1024;
  #define DMA_K(t,slot) glds16(ksrc+(long)(t)*KVBLK*PQ,(unsigned)__builtin_amdgcn_readfirstlane(kdst+(slot)))
  #define DMA_V(t,slot) glds16(vsrc+(long)(t)*KVBLK*PQ,(unsigned)__builtin_amdgcn_readfirstlane(vdst+(slot)))
  const int vb0=(int)(lds0+LDS_V)+((lane>>4)&1)*32+(lane&3)*8+(4*hi+((lane&15)>>2))*64;
  const char*Kbase=shm+LDS_K; bf16x8 kf[8];
  const lds_cptr shm3=(lds_cptr)shm; const lds_cptr kp0=shm3+LDS_K+hi*1024+r32*16; const lds_cptr vp0=shm3+LDS_V+((lane>>4)&1)*32+(lane&3)*8+(4*hi+((lane&15)>>2))*64;
  const int NT=(q0+QB)/KVBLK;
  if(FOX){ float*bl=(float*)(shm+LDS_BIAS); for(int i=tid;i<(q0+QB)/4;i+=NW*64)((f32x4_t*)bl)[i]=((const f32x4_t*)CB)[i]; asm volatile("s_waitcnt vmcnt(0) lgkmcnt(0)":::"memory"); }
  const lds_cptr bp0=(lds_cptr)shm+LDS_BIAS+hi*16;
  DMA_K(0,0);DMA_V(0,0);DMA_K(1,SLOTB);
  bf16x8 qr[4];
  #pragma unroll
  for(int d0=0;d0<4;++d0)qr[d0]=*reinterpret_cast<const bf16x8*>(&Qw[(long)r32*PQ+d0*16+hi*8]);
  float mhat=0.f,l_reg=0.f;f32x16 o[2];o[0]=f32x16{};o[1]=f32x16{};float z0_;asm volatile("v_mov_b32 %0, 0":"=v"(z0_));f32x16 negm;_Pragma("unroll") for(int r=0;r<16;++r)negm[r]=z0_;asm volatile("":"+v"(negm));
  const int qrel=wid*QBLK+r32;
  #define CMASK(P0,P1,t) do{int jb_=(t)-(NT-4); if(jb_>=0)cmask(P0,P1,jb_,qrel,hi);}while(0)
  #define BIASADD(P0,P1,t) do{ if(FOX){ const lds_cptr bq_=bp0+(t)*256; _Pragma("unroll") for(int g_=0;g_<4;++g_){ const f32x4_t b0_=*(const __attribute__((address_space(3))) f32x4_t*)(bq_+g_*32), b1_=*(const __attribute__((address_space(3))) f32x4_t*)(bq_+g_*32+128); \
      _Pragma("unroll") for(int e_=0;e_<4;++e_){ P0[4*g_+e_]+=b0_[e_]; P1[4*g_+e_]+=b1_[e_]; } } } }while(0)
  bool resc=false;
  #define START(P0,P1) do{ const float rm=rowmax(P0,P1); resc=false; \
    { const float dl=rm; mhat=fadd_s(mhat,dl); \
      _Pragma("unroll") for(int r=0;r<16;++r){P0[r]=fsub_s(P0[r],dl);P1[r]=fsub_s(P1[r],dl);} \
      _Pragma("unroll") for(int r=0;r<16;++r)negm[r]=-mhat; asm volatile("":"+v"(negm)); } \
    _Pragma("unroll") for(int r=0;r<16;++r)P0[r]=__builtin_amdgcn_exp2f(P0[r]); }while(0)
  #define RESC() do{ if(resc){ asm volatile("s_waitcnt lgkmcnt(0)":::"memory"); \
      _Pragma("unroll") for(int d_=0;d_<2;++d_) _Pragma("unroll") for(int r=0;r<16;++r)o[d_][r]*=wsf[crow(r,hi)]; } }while(0)
  f32x16 pA0,pA1,pB0,pB1;
  int sl_prev=0,sl_cur=0,sl_next=SLOTB;
  #define ROT() do{sl_prev=sl_cur;sl_cur=sl_next;sl_next=(sl_next==(NSLOT-1)*SLOTB)?0:sl_next+SLOTB;}while(0)
  DMA_K(2,2*SLOTB);
  WAIT_BAR(3);
  qkt(pA0,pA1,Kbase,qr,negm,r32,hi);asm volatile("s_nop 15\n\ts_nop 7":"+v"(pA0),"+v"(pA1));BIASADD(pA0,pA1,0);CMASK(pA0,pA1,0);
  START(pA0,pA1);
  _Pragma("unroll") for(int r=0;r<16;++r)pA1[r]=__builtin_amdgcn_exp2f(pA1[r]);
  WAIT_BAR(0);
  DMA_K(3,0);DMA_V(1,SLOTB);
  ROT();
  kload8(kf,kp0+sl_cur);
  WAIT_BAR(2);
  s16x4 vlo[8],vhi[8]; u32x4 pw0,pw1,pw2,pw3;
  #define PKW(P,B) cvtpk_s(P[B],P[B+1])
  #define PAF(k) __builtin_bit_cast(bf16x8,pw##k)
  #define VFR(i) (bf16x8){vlo[i][0],vlo[i][1],vlo[i][2],vlo[i][3],vhi[i][0],vhi[i][1],vhi[i][2],vhi[i][3]}
  #define PIN(x) asm volatile("":"+v"(x))
  #define MX3(a,b,c) __builtin_fmaxf(__builtin_fmaxf((a),(b)),(c))
  #define GAPA(MF,A0,A1,A2,A3,W0,W1,PW) do{ MF; sacc+=A0; sacc+=A1; sacc+=A2; sacc+=A3; PIN(sacc); W0; W1; PIN(PW); SBAR(); }while(0)
  #define EX(v) __builtin_amdgcn_exp2f(v)
  #define GAPB(MF,X,B) do{ MF; X[B]=EX(X[B]); X[B+1]=EX(X[B+1]); X[B+2]=EX(X[B+2]); X[B+3]=EX(X[B+3]); PIN(X); SBAR(); }while(0)
  #define VRD(i) do{ vlo[i]=vtr(vp_+(((i)>>2)*4096+((i)&3)*1024)); vhi[i]=vtr(vp_+(((i)>>2)*4096+((i)&3)*1024+512)); }while(0)
  #define KRD(G,j) do{ if(G){ kload2(kf,kp0+sl_next,j); SBAR(); } }while(0)
  #define STEP(C0,C1,P0,P1,t,GK,GV,GL) do{ SBAR(); \
    const lds_cptr vp_=vp0+sl_prev; \
    VRD(0); SBAR(); float sacc=(P0[0]+P0[1]); \
    GAPA(C0=__builtin_amdgcn_mfma_f32_32x32x16_bf16(kf[0],qr[0],negm,0,0,0), P0[2],P0[3],P0[4],P0[5],     pw0[0]=PKW(P0,0), pw0[1]=PKW(P0,2), pw0); \
    VRD(4); SBAR(); GAPA(C1=__builtin_amdgcn_mfma_f32_32x32x16_bf16(kf[1],qr[0],negm,0,0,0), P0[6],P0[7],P0[8],P0[9],     pw0[2]=PKW(P0,4), pw0[3]=PKW(P0,6), pw0); \
    VRD(1); SBAR(); GAPA(C0=__builtin_amdgcn_mfma_f32_32x32x16_bf16(kf[2],qr[1],C0,0,0,0),   P0[10],P0[11],P0[12],P0[13], pw1[0]=PKW(P0,8), pw1[1]=PKW(P0,10), pw1); \
    VRD(5); SBAR(); GAPA(C1=__builtin_amdgcn_mfma_f32_32x32x16_bf16(kf[3],qr[1],C1,0,0,0),   P0[14],P0[15],P1[0],P1[1],   pw1[2]=PKW(P0,12),pw1[3]=PKW(P0,14), pw1); \
    VRD(2); SBAR(); GAPA(C0=__builtin_amdgcn_mfma_f32_32x32x16_bf16(kf[4],qr[2],C0,0,0,0),   P1[2],P1[3],P1[4],P1[5],     pw2[0]=PKW(P1,0), pw2[1]=PKW(P1,2), pw2); \
    VRD(6); SBAR(); GAPA(C1=__builtin_amdgcn_mfma_f32_32x32x16_bf16(kf[5],qr[2],C1,0,0,0),   P1[6],P1[7],P1[8],P1[9],     pw2[2]=PKW(P1,4), pw2[3]=PKW(P1,6), pw2); \
    VRD(3); SBAR(); GAPA(C0=__builtin_amdgcn_mfma_f32_32x32x16_bf16(kf[6],qr[3],C0,0,0,0),   P1[10],P1[11],P1[12],P1[13], pw3[0]=PKW(P1,8), pw3[1]=PKW(P1,10), pw3); \
    VRD(7); SBAR(); GAPA(C1=__builtin_amdgcn_mfma_f32_32x32x16_bf16(kf[7],qr[3],C1,0,0,0),   P1[14],P1[15],0.f,0.f,       pw3[2]=PKW(P1,12),pw3[3]=PKW(P1,14), pw3); \
    l_reg+=sacc; \
    if(GK){DMA_K((t)+3,sl_cur);} if(GV){DMA_V((t)+1,sl_next);} \
    BIASADD(C0,C1,t); CMASK(C0,C1,t); \
    { float a=MX3(C0[0],C0[1],C1[0]),b=MX3(C0[2],C0[3],C1[1]); a=MX3(a,C1[2],C1[3]); \
      _Pragma("unroll") for(int r=4;r<16;r+=4){a=MX3(a,C0[r],C0[r+1]);b=MX3(b,C0[r+2],C0[r+3]);a=MX3(a,C1[r],C1[r+1]);b=MX3(b,C1[r+2],C1[r+3]);} \
      float rm=__builtin_fmaxf(a,b); { auto rr=__builtin_amdgcn_permlane32_swap(__float_as_uint(rm),__float_as_uint(rm),false,false); rm=__builtin_fmaxf(__uint_as_float(rr[0]),__uint_as_float(rr[1])); } \
      resc=false; \
      if(__builtin_expect(__any(rm>(float)THRL),0)){ const float dl=__builtin_fmaxf(rm,0.f); mhat+=dl; \
        _Pragma("unroll") for(int r=0;r<16;++r){C0[r]-=dl;C1[r]-=dl;} \
        _Pragma("unroll") for(int r=0;r<16;++r)negm[r]=-mhat; asm volatile("":"+v"(negm)); \
        const float f=__builtin_amdgcn_exp2f(-dl); l_reg*=f; if(hi==0)wsf[r32]=f; resc=true; } } \
    SBAR(); \
    GAPB(o[0]=__builtin_amdgcn_mfma_f32_32x32x16_bf16(PAF(0),VFR(0),o[0],0,0,0), C0,0); \
    GAPB(o[1]=__builtin_amdgcn_mfma_f32_32x32x16_bf16(PAF(0),VFR(4),o[1],0,0,0), C0,4); \
    KRD(GL,0); GAPB(o[0]=__builtin_amdgcn_mfma_f32_32x32x16_bf16(PAF(1),VFR(1),o[0],0,0,0), C0,8); \
    KRD(GL,1); GAPB(o[1]=__builtin_amdgcn_mfma_f32_32x32x16_bf16(PAF(1),VFR(5),o[1],0,0,0), C0,12); \
    KRD(GL,2); GAPB(o[0]=__builtin_amdgcn_mfma_f32_32x32x16_bf16(PAF(2),VFR(2),o[0],0,0,0), C1,0); \
    KRD(GL,3); GAPB(o[1]=__builtin_amdgcn_mfma_f32_32x32x16_bf16(PAF(2),VFR(6),o[1],0,0,0), C1,4); \
    GAPB(o[0]=__builtin_amdgcn_mfma_f32_32x32x16_bf16(PAF(3),VFR(3),o[0],0,0,0), C1,8); \
    GAPB(o[1]=__builtin_amdgcn_mfma_f32_32x32x16_bf16(PAF(3),VFR(7),o[1],0,0,0), C1,12); \
    }while(0)
  int t=1;
  #undef CMASK
  #define CMASK(P0,P1,t) do{}while(0)
  for(;t+5<NT;t+=2){
    STEP(pB0,pB1,pA0,pA1,t,true,true,true);     WAIT_BAR(2); RESC(); ROT();
    STEP(pA0,pA1,pB0,pB1,t+1,true,true,true);   WAIT_BAR(2); RESC(); ROT();
  }
  #undef CMASK
  #define CMASK(P0,P1,t) do{int jb_=(t)-(NT-4); if(jb_>=0)cmask(P0,P1,jb_,qrel,hi);}while(0)
  #define ENDW(tt) do{ if((tt)+3<NT){WAIT_BAR(2);} else if((tt)+2<NT){WAIT_BAR(1);} else {WAIT_BAR(0);} }while(0)
  for(;t+1<NT;t+=2){
    STEP(pB0,pB1,pA0,pA1,t,(t+3<NT),(t+1<NT),(t+1<NT));       ENDW(t);   RESC(); ROT();
    STEP(pA0,pA1,pB0,pB1,t+1,(t+4<NT),(t+2<NT),(t+2<NT));     ENDW(t+1); RESC(); ROT();
  }
  STEP(pB0,pB1,pA0,pA1,NT-1,false,false,false); RESC();
  { float sacc=pB0[0]+pB0[1]; _Pragma("unroll") for(int r=2;r<16;++r)sacc+=pB0[r]; _Pragma("unroll") for(int r=0;r<16;++r)sacc+=pB1[r]; l_reg+=sacc;
    pw0=(u32x4){PKW(pB0,0),PKW(pB0,2),PKW(pB0,4),PKW(pB0,6)};pw1=(u32x4){PKW(pB0,8),PKW(pB0,10),PKW(pB0,12),PKW(pB0,14)};pw2=(u32x4){PKW(pB1,0),PKW(pB1,2),PKW(pB1,4),PKW(pB1,6)};pw3=(u32x4){PKW(pB1,8),PKW(pB1,10),PKW(pB1,12),PKW(pB1,14)};
    SBAR(); pv(o,vb0+sl_cur,PAF(0),PAF(1),PAF(2),PAF(3)); }
  #undef PKW
  #undef PAF
  #undef VFR
  #undef PIN
  #undef MX3
  #undef GAPA
  #undef GAPB
  #undef EX
  #undef VRD
  #undef KRD
  #undef STEP
  #undef ENDW
  {auto rr=__builtin_amdgcn_permlane32_swap(__float_as_uint(l_reg),__float_as_uint(l_reg),false,false);l_reg=__uint_as_float(rr[0])+__uint_as_float(rr[1]);}
  if(hi==0)wsf[32+r32]=l_reg;asm volatile("s_waitcnt lgkmcnt(0)":::"memory");
  float rli[16];
  #pragma unroll
  for(int r=0;r<16;++r)rli[r]=__builtin_amdgcn_rcpf(wsf[32+crow(r,hi)]);
  bf16*Ow=O+(rowbase+q0+wid*QBLK)*PO+ocol;
  { bf16*stg=(bf16*)(shm+LDS_OST)+wid*2048;
    #pragma unroll
    for(int r=0;r<16;++r){const int orow=crow(r,hi);
      #pragma unroll
      for(int d0=0;d0<2;++d0)stg[orow*64+d0*32+r32]=__float2bfloat16(o[d0][r]*rli[r]);}
    asm volatile("s_waitcnt lgkmcnt(0)":::"memory");
    #pragma unroll
    for(int i=0;i<4;++i){const int row=i*8+(lane>>3),ch=lane&7; const u32x4 v=*(const u32x4*)(stg+row*64+ch*8); ATTN_STORE16(Ow+(long)row*PO+ch*8,v);} }
  asm volatile("s_waitcnt lgkmcnt(0)\n\ts_barrier":::"memory");
  #undef DMA_K
  #undef DMA_V
  #undef CMASK
  #undef BIASADD
  #undef START
  #undef RESC
  #undef ROT
}
constexpr int ATTN_LDS_BYTES=LDS_BYTES;
#undef SBAR
#undef WAIT_BAR
}
#define LAS __attribute__((address_space(3)))
__device__ __forceinline__ void transpose_item(const float* __restrict__ W, int K, int ldw, int ncols, bf16* __restrict__ WT, LAS float* scr, int item, int lane) {
    const int nblk = ncols / 32, kb = item / nblk, nb = item % nblk, k0 = 64 * kb, n0 = 32 * nb;
#pragma unroll 8
    for (int i = 0; i < 32; ++i) { const int kk = 2 * i + (lane >> 5); scr[kk * 33 + (lane & 31)] = W[(size_t)(k0 + kk) * ldw + n0 + (lane & 31)]; }
    asm volatile("s_waitcnt lgkmcnt(0)" ::: "memory");
    const int c = lane & 7;
#pragma unroll
    for (int j = 0; j < 4; ++j) { const int n = (lane >> 3) + 8 * j; const LAS float* s = scr + (8 * c) * 33 + n;
        u32x4 o; o.x = pk2(s[0 * 33], s[1 * 33]); o.y = pk2(s[2 * 33], s[3 * 33]); o.z = pk2(s[4 * 33], s[5 * 33]); o.w = pk2(s[6 * 33], s[7 * 33]);
        *(u32x4*)(WT + (size_t)(n0 + n) * K + k0 + 8 * c) = o; }
    asm volatile("s_waitcnt lgkmcnt(0)" ::: "memory");
}
__device__ __forceinline__ void ph_prologue(const P& p, LAS unsigned char* lds, int bid, int nb) {
    const int tid = opaque_tid(), lane = tid & 63, wave = __builtin_amdgcn_readfirstlane(tid >> 6);
    const int gw = bid * NWAVE + wave, ngw = nb * NWAVE;
    if (bid == 0 && tid < 64) ((unsigned*)(p.ws + WS_CTL))[tid] = 0u;
    {
        LAS float* scr = (LAS float*)(lds + wave * 16384);
        constexpr int I_IN = (D / 64) * (NPROJ / 32), I_O = (D / 64) * (D / 32), I_G = I_O, I_P = (PLE / 64) * (D / 32);
        constexpr int I_E1 = (D / 64) * (2 * DE / 32), I_E2 = (DE / 64) * (D / 32);
        constexpr int NITEMS = I_IN + I_O + I_G + I_P + NE * (I_E1 + I_E2);
        for (int it = gw; it < NITEMS; it += ngw) {
            int r = it;
            if (r < I_IN) { transpose_item(p.w_in, D, INW, NPROJ, (bf16*)(p.ws + WS_WIN_T), scr, r, lane); continue; } r -= I_IN;
            if (r < I_O) { transpose_item(p.w_out, D, D, D, (bf16*)(p.ws + WS_WO_T), scr, r, lane); continue; } r -= I_O;
            if (r < I_G) { transpose_item(p.w_gate, D, D, D, (bf16*)(p.ws + WS_WG_T), scr, r, lane); continue; } r -= I_G;
            if (r < I_P) { transpose_item(p.w_proj, PLE, D, D, (bf16*)(p.ws + WS_WP_T), scr, r, lane); continue; } r -= I_P;
            const int e = r / (I_E1 + I_E2); r -= e * (I_E1 + I_E2);
            if (r < I_E1) transpose_item(p.w_e1 + (size_t)e * D * 2 * DE, D, 2 * DE, 2 * DE, (bf16*)(p.ws + WS_W1_T) + (size_t)e * 2 * DE * D, scr, r, lane);
            else transpose_item(p.w_e2 + (size_t)e * DE * D, DE, D, D, (bf16*)(p.ws + WS_W2_T) + (size_t)e * D * DE, scr, r - I_E1, lane);
        }
    }
    bf16* XN = (bf16*)(p.ws + WS_XN); bf16* PB = (bf16*)(p.ws + WS_PB);
    float* LOGF = (float*)(p.ws + WS_LOGF); float* COS = (float*)(p.ws + WS_COS); float* SIN = (float*)(p.ws + WS_SIN);
    for (int m = gw; m < M; m += ngw) {
        const f32x4* xr = (const f32x4*)(p.x + (size_t)m * D) + lane;
        f32x4 v[4]; float ss = 0.f;
#pragma unroll
        for (int j = 0; j < 4; ++j) { v[j] = xr[64 * j]; ss += (v[j].x * v[j].x + v[j].y * v[j].y) + (v[j].z * v[j].z + v[j].w * v[j].w); }
        { const f32x4 pv = ((const f32x4*)(p.p + (size_t)m * PLE))[lane]; u32x2 o; o.x = pk2(pv.x, pv.y); o.y = pk2(pv.z, pv.w); ((u32x2*)(PB + (size_t)m * PLE))[lane] = o; }
        const float rstd = 1.0f / sqrtf(wave_sum(ss) * (1.f / D) + EPS);
        float fz[8];
#pragma unroll
        for (int i = 0; i < 8; ++i) fz[i] = 0.f;
#pragma unroll
        for (int j = 0; j < 4; ++j) {
            const f32x4 g = ((const f32x4*)p.g_attn)[lane + 64 * j];
            v[j] = v[j] * rstd * g;
            const int k = 4 * lane + 256 * j;
#pragma unroll
            for (int e = 0; e < 4; ++e) {
                const float* wr_ = p.w_in + (size_t)(k + e) * INW + NPROJ;
                const f32x4 w0 = *(const f32x4*)wr_, w1 = *(const f32x4*)(wr_ + 4);
                const float y = v[j][e];
                fz[0] += y * w0.x; fz[1] += y * w0.y; fz[2] += y * w0.z; fz[3] += y * w0.w;
                fz[4] += y * w1.x; fz[5] += y * w1.y; fz[6] += y * w1.z; fz[7] += y * w1.w;
            }
            u32x2 o; o.x = pk2(v[j].x, v[j].y); o.y = pk2(v[j].z, v[j].w);
            *((u32x2*)(XN + (size_t)m * D) + lane + 64 * j) = o;
        }
#pragma unroll
        for (int i = 0; i < 8; ++i) fz[i] = wave_sum(fz[i]);
        if (lane < 8) {
            float z = 0.f;
#pragma unroll
            for (int i = 0; i < 8; ++i) z = (lane == i) ? fz[i] : z;
            z += p.b_forget[lane];
            LOGF[(size_t)m * 8 + lane] = fminf(z, 0.f) - log1pf(__expf(-fabsf(z)));
            const double invf = exp2(-(double)lane * 0.125 * 18.931568569324174);
            const double ang = (double)p.pos[m] * invf;
            const double kq = rint(ang * 0.15915494309189535);
            const double r = (ang - kq * 6.283185307179586) - kq * 2.4492935982947064e-16;
            const float rf = (float)r;
            COS[(size_t)m * 8 + lane] = cosf(rf); SIN[(size_t)m * 8 + lane] = sinf(rf);
        }
    }
}

__device__ __forceinline__ void ph_inproj(const P& p, LAS unsigned char* lds, int bid, int nb) {
    const int tid = opaque_tid(), lane = tid & 63, wave = tid >> 6;
    {
        const int gw = bid * NWAVE + wave;
        if (gw < NB * 8) {
            const int b = gw >> 3, h = gw & 7;
            const float* LOGF = (const float*)(p.ws + WS_LOGF); float* CB = (float*)(p.ws + WS_CUM) + (size_t)gw * SEQ;
            float loc[32]; float s = 0.f;
#pragma unroll
            for (int i = 0; i < 32; ++i) { s += LOGF[(size_t)(b * SEQ + lane * 32 + i) * 8 + h]; loc[i] = s; }
            float inc = s;
#pragma unroll
            for (int o = 1; o < 64; o <<= 1) { const float t = __shfl_up(inc, o); if (lane >= o) inc += t; }
            const float excl = inc - s;
#pragma unroll
            for (int i = 0; i < 32; ++i) CB[lane * 32 + i] = -(excl + loc[i]) * LOG2E;
        }
        asm volatile("s_waitcnt vmcnt(0)" ::: "memory"); __syncthreads();
    }
    {
        pg8::DenseSched S; S.init(p.ws + WS_XN, p.ws + WS_WIN_T, M, NPROJ, D, nb, bid);
        pg8::EpiInproj E{(bf16*)(p.ws + WS_PROJ), (const float*)(p.ws + WS_COS), (const float*)(p.ws + WS_SIN)};
        pg8::gemm_phase<pg8::EpiInproj, pg8::DenseSched, true>(lds, D, S, E);
    }
    {
        pg8::DenseSched S; S.init(p.ws + WS_PB, p.ws + WS_WP_T, M, D, PLE, nb, bid);
        pg8::EpiBf16 E{(bf16*)(p.ws + WS_PP), D};
        pg8::gemm_phase<pg8::EpiBf16, pg8::DenseSched, true>(lds, PLE, S, E);
    }
}

struct AUnit { int b, qb, qcol, kcol, vcol, ocol, cb; };
struct FoxOrder {
    int vcu, nb;
    __device__ __forceinline__ bool next(int i, AUnit& u) const {
        const int fp = vcu + (i >> 1) * nb; if (fp >= 256) return false;
        const int hf = (fp >> 2) & 7, s = fp & 3;
        u.b = fp >> 5; u.qb = (i & 1) ? 7 - s : s; u.qcol = 1536 + hf * 64; u.kcol = 2048 + hf * 64; u.vcol = 2560 + hf * 64; u.ocol = 512 + hf * 64; u.cb = u.b * 8 + hf; return true;
    }
};
struct DiffOrder {
    int vcu, nb;
    __device__ __forceinline__ bool next(int i, AUnit& u) const {
        const int v = vcu + (i >> 2) * nb; if (2 * v >= 512) return false;
        const int dp = 2 * v + ((i >> 1) & 1), pr = (dp >> 2) & 15, s = dp & 3, h = pr >> 2, mm = (pr >> 1) & 1, vh = pr & 1;
        u.b = dp >> 6; u.qb = (i & 1) ? 7 - s : s; u.qcol = h * 128 + mm * 64; u.kcol = 512 + u.qcol; u.vcol = 1024 + h * 128 + vh * 64; u.ocol = mm * 512 + h * 128 + vh * 64; u.cb = 0; return true;
    }
};
__device__ __forceinline__ void ph_attn(const P& p, char* shm, int bid, int nb) {
    typedef attn_body::bf16 abf;
    const int vcu = (nb % 8 == 0) ? (bid % 8) * (nb / 8) + bid / 8 : bid;
    const abf* PROJ = (const abf*)(p.ws + WS_PROJ); const float* CB = (const float*)(p.ws + WS_CUM);
    AUnit u;
    { const FoxOrder S{vcu, nb};
      for (int i = 0; S.next(i, u); ++i) attn_body::attn_unit<8, true>(u.b, u.qb, u.qcol, u.kcol, u.vcol, u.ocol, PROJ, PROJ, PROJ, (abf*)(p.ws + WS_MIXED), CB + (size_t)u.cb * SEQ, shm); }
    { const DiffOrder S{vcu, nb};
      for (int i = 0; S.next(i, u); ++i) attn_body::attn_unit<8, false>(u.b, u.qb, u.qcol, u.kcol, u.vcol, u.ocol, PROJ, PROJ, PROJ, (abf*)(p.ws + WS_OATT), nullptr, shm); }
}

__device__ void ph_combine(const P& p, int bid, int nb) {
    const int tid = opaque_tid(), lane = tid & 63, wave = tid >> 6;
    const int gw = bid * NWAVE + wave, ngw = nb * NWAVE;
    const float lam = __expf(wave_sum(p.lq1[lane] * p.lk1[lane])) - __expf(wave_sum(p.lq2[lane] * p.lk2[lane])) + LAMBDA_INIT;
    const bf16* OATT = (const bf16*)(p.ws + WS_OATT); bf16* MIXED = (bf16*)(p.ws + WS_MIXED);
    const float g0 = p.g_subln[2 * lane], g1 = p.g_subln[2 * lane + 1];
    for (int m = gw; m < M; m += ngw) {
#pragma unroll
        for (int h = 0; h < 4; ++h) {
            const unsigned a = *(const unsigned*)(OATT + (size_t)m * D + h * 128 + 2 * lane), c = *(const unsigned*)(OATT + (size_t)m * D + 512 + h * 128 + 2 * lane);
            const float d0 = bf2f(a & 0xffffu) - lam * bf2f(c & 0xffffu), d1 = bf2f(a >> 16) - lam * bf2f(c >> 16);
            const float rstd = 1.0f / sqrtf(wave_sum(d0 * d0 + d1 * d1) * (1.f / 128.f) + EPS);
            *(unsigned*)(MIXED + (size_t)m * D + h * 128 + 2 * lane) = pk2(d0 * rstd * g0 * (1.f - LAMBDA_INIT), d1 * rstd * g1 * (1.f - LAMBDA_INIT));
        }
    }
}

__device__ __forceinline__ void ph_outproj(const P& p, LAS unsigned char* lds, int bid, int nb) {
    pg8::DenseSched S; S.init(p.ws + WS_MIXED, p.ws + WS_WO_T, M, D, D, nb, bid);
    pg8::EpiResF32 E{p.x, (float*)(p.ws + WS_H1), D};
    pg8::gemm_phase<pg8::EpiResF32, pg8::DenseSched, true>(lds, D, S, E);
}

__device__ void ph_route(const P& p, int bid, int nb) {
    const int tid = opaque_tid(), lane = tid & 63, wave = tid >> 6;
    const int gw = bid * NWAVE + wave, ngw = nb * NWAVE;
    const float* H1 = (const float*)(p.ws + WS_H1); bf16* XN = (bf16*)(p.ws + WS_XN);
    unsigned* CNT = (unsigned*)(p.ws + WS_CTL); int* LIST = (int*)(p.ws + WS_LIST); float* GATE = (float*)(p.ws + WS_GATE);
    for (int m = gw; m < M; m += ngw) {
        const f32x4* xr = (const f32x4*)(H1 + (size_t)m * D) + lane;
        f32x4 v[4]; float ss = 0.f;
#pragma unroll
        for (int j = 0; j < 4; ++j) { v[j] = xr[64 * j]; ss += (v[j].x * v[j].x + v[j].y * v[j].y) + (v[j].z * v[j].z + v[j].w * v[j].w); }
        const float rstd = 1.0f / sqrtf(wave_sum(ss) * (1.f / D) + EPS);
        float lg[32];
#pragma unroll
        for (int e = 0; e < 32; ++e) lg[e] = 0.f;
#pragma unroll
        for (int j = 0; j < 4; ++j) {
            const f32x4 g = ((const f32x4*)p.g_moe)[lane + 64 * j];
            v[j] = v[j] * rstd * g;
            const int k = 4 * lane + 256 * j;
#pragma unroll
            for (int e4 = 0; e4 < 4; ++e4) {
                const f32x4* wr_ = (const f32x4*)(p.w_router + (size_t)(k + e4) * NE);
                const float y = v[j][e4];
#pragma unroll
                for (int q = 0; q < 8; ++q) { const f32x4 w = wr_[q]; lg[4 * q] += y * w.x; lg[4 * q + 1] += y * w.y; lg[4 * q + 2] += y * w.z; lg[4 * q + 3] += y * w.w; }
            }
            u32x2 o; o.x = pk2(v[j].x, v[j].y); o.y = pk2(v[j].z, v[j].w);
            *((u32x2*)(XN + (size_t)m * D) + lane + 64 * j) = o;
        }
#pragma unroll
        for (int e = 0; e < 32; ++e) lg[e] = wave_sum(lg[e]) + p.b_router[e];
        int idx[4]; float val[4];
#pragma unroll
        for (int k = 0; k < 4; ++k) {
            float best = -INFINITY; int bi = 0;
#pragma unroll
            for (int e = 0; e < 32; ++e) { const bool take = lg[e] > best; best = take ? lg[e] : best; bi = take ? e : bi; }
            idx[k] = bi; val[k] = best;
#pragma unroll
            for (int e = 0; e < 32; ++e) lg[e] = (e == bi) ? -INFINITY : lg[e];
        }
        const float e1 = __expf(val[1] - val[0]), e2 = __expf(val[2] - val[0]), e3 = __expf(val[3] - val[0]);
        const float rs = 1.f / (1.f + e1 + e2 + e3);
        if (lane < 4) {
            const int e = lane == 0 ? idx[0] : lane == 1 ? idx[1] : lane == 2 ? idx[2] : idx[3];
            const float gt = (lane == 0 ? 1.f : lane == 1 ? e1 : lane == 2 ? e2 : e3) * rs;
            const unsigned pos = atomicAdd(&CNT[e], 1u);
            LIST[e * M + pos] = m * 4 + lane;
            GATE[(size_t)m * 4 + lane] = gt;
        }
    }
}

template <int MODE> __device__ __forceinline__ void moe_setup(const P& p, LAS unsigned char* lds, int nN, int bid, int nb) {
    const int tid = opaque_tid();
    LAS pg8::MoeTab* T = (LAS pg8::MoeTab*)(lds + LDS_TAB); LAS int* rowmap = (LAS int*)(lds + LDS_ROWMAP);
    const unsigned* CNT = (const unsigned*)(p.ws + WS_CTL); const int* LIST = (const int*)(p.ws + WS_LIST);
    if (tid == 0) { int ts = 0, rb = 0;
        for (int e = 0; e < NE; ++e) { const int c = (int)CNT[e], mt = (c + 255) >> 8; T->tstart[e] = ts; T->rbase[e] = rb; T->cnt[e] = c; T->mt[e] = mt; ts += mt * nN; rb += mt * 256; }
        T->tstart[32] = ts; }
    __syncthreads();
    pg8::MoeSched<MODE> S{T, rowmap, nN, nb, bid, 0, nullptr, nullptr, 0};
    pg8::Unit u;
    for (int i = 0; i < 9 && S.next(i, u); ++i)
        if (tid < 256) { const int rr = u.pm * 256 + tid; const int v = rr < T->cnt[u.e] ? LIST[u.e * M + rr] : -1; rowmap[i * 256 + tid] = MODE == 1 ? (v < 0 ? 0 : (v >> 2)) : v; }
    __syncthreads();
}
__device__ __forceinline__ void ph_moe1(const P& p, LAS unsigned char* lds, int bid, int nb) {
    moe_setup<1>(p, lds, 8, bid, nb);
    const LAS pg8::MoeTab* T = (const LAS pg8::MoeTab*)(lds + LDS_TAB); const LAS int* rowmap = (const LAS int*)(lds + LDS_ROWMAP);
    pg8::MoeSched<1> S{T, rowmap, 8, nb, bid, D, (const char*)(p.ws + WS_XN), (const char*)(p.ws + WS_W1_T), (size_t)2 * DE * D * 2};
    pg8::EpiMoe1 E{(bf16*)(p.ws + WS_ACT), p.b_e1, T};
    pg8::gemm_phase<pg8::EpiMoe1, pg8::MoeSched<1>, true>(lds, D, S, E);
}
__device__ __forceinline__ void ph_moe2(const P& p, LAS unsigned char* lds, int bid, int nb) {
    moe_setup<2>(p, lds, 4, bid, nb);
    const LAS pg8::MoeTab* T = (const LAS pg8::MoeTab*)(lds + LDS_TAB); const LAS int* rowmap = (const LAS int*)(lds + LDS_ROWMAP);
    pg8::MoeSched<2> S{T, rowmap, 4, nb, bid, DE, (const char*)(p.ws + WS_ACT), (const char*)(p.ws + WS_W2_T), (size_t)D * DE * 2};
    pg8::EpiMoe2 E{(bf16*)(p.ws + WS_Y), p.b_e2, rowmap};
    pg8::gemm_phase<pg8::EpiMoe2, pg8::MoeSched<2>, true>(lds, DE, S, E);
}

__device__ void ph_combine2(const P& p, int bid, int nb) {
    const int tid = opaque_tid(), lane = tid & 63, wave = tid >> 6;
    const int gw = bid * NWAVE + wave, ngw = nb * NWAVE;
    const float* H1 = (const float*)(p.ws + WS_H1); float* H2 = (float*)(p.ws + WS_H2); bf16* XN = (bf16*)(p.ws + WS_XN);
    const bf16* Y = (const bf16*)(p.ws + WS_Y); const float* GATE = (const float*)(p.ws + WS_GATE);
    for (int m = gw; m < M; m += ngw) {
        const f32x4 gt = *(const f32x4*)(GATE + (size_t)m * 4);
        f32x4 v[4]; float ss = 0.f;
#pragma unroll
        for (int j = 0; j < 4; ++j) {
            v[j] = ((const f32x4*)(H1 + (size_t)m * D))[lane + 64 * j];
#pragma unroll
            for (int k = 0; k < 4; ++k) {
                const u32x2 w = *((const u32x2*)(Y + (size_t)(m * 4 + k) * D) + lane + 64 * j);
                const float g = gt[k];
                v[j].x += g * bf2f(w.x & 0xffffu); v[j].y += g * bf2f(w.x >> 16); v[j].z += g * bf2f(w.y & 0xffffu); v[j].w += g * bf2f(w.y >> 16);
            }
            ((f32x4*)(H2 + (size_t)m * D))[lane + 64 * j] = v[j];
            ss += (v[j].x * v[j].x + v[j].y * v[j].y) + (v[j].z * v[j].z + v[j].w * v[j].w);
        }
        const float rstd = 1.0f / sqrtf(wave_sum(ss) * (1.f / D) + EPS);
#pragma unroll
        for (int j = 0; j < 4; ++j) {
            const f32x4 g = ((const f32x4*)p.g_ple)[lane + 64 * j];
            const f32x4 y = v[j] * rstd * g;
            u32x2 o; o.x = pk2(y.x, y.y); o.y = pk2(y.z, y.w);
            *((u32x2*)(XN + (size_t)m * D) + lane + 64 * j) = o;
        }
    }
}

__device__ __forceinline__ void ph_gate(const P& p, LAS unsigned char* lds, int bid, int nb) {
    pg8::DenseSched S; S.init(p.ws + WS_XN, p.ws + WS_WG_T, M, D, D, nb, bid);
    pg8::EpiGate E{(const float*)(p.ws + WS_H2), (const bf16*)(p.ws + WS_PP), p.out, D};
    pg8::gemm_phase<pg8::EpiGate, pg8::DenseSched, true>(lds, D, S, E);
}

__device__ void ph_final(const P& p, int bid, int nb) {
    const int tid = opaque_tid(), lane = tid & 63, wave = tid >> 6;
    const int gw = bid * NWAVE + wave, ngw = nb * NWAVE;
    for (int m = gw; m < M; m += ngw) {
        f32x4* xr = (f32x4*)(p.out + (size_t)m * D) + lane;
        f32x4 v[4]; float ss = 0.f;
#pragma unroll
        for (int j = 0; j < 4; ++j) { v[j] = xr[64 * j]; ss += (v[j].x * v[j].x + v[j].y * v[j].y) + (v[j].z * v[j].z + v[j].w * v[j].w); }
        const float rstd = 1.0f / sqrtf(wave_sum(ss) * (1.f / D) + EPS);
#pragma unroll
        for (int j = 0; j < 4; ++j) xr[64 * j] = v[j] * rstd * ((const f32x4*)p.g_final)[lane + 64 * j];
    }
}

__global__ void __launch_bounds__(NT, 2) k_mega(P p) {
    extern __shared__ __attribute__((aligned(16))) unsigned char lds_raw[];
    LAS unsigned char* lds = (LAS unsigned char*)lds_raw;
    cg::grid_group grid = cg::this_grid();
    const int bid = blockIdx.x, nb = gridDim.x;
#if defined(__HIP_DEVICE_COMPILE__)
#define PH(call) do { typedef const __attribute__((address_space(4))) P CP; CP* kp_ = (CP*)__builtin_amdgcn_kernarg_segment_ptr(); asm volatile("" : "+s"(kp_)); const P q = *kp_; call; } while (0)
#else
#define PH(call) do { const P q = p; call; } while (0)
#endif
    PH(ph_prologue(q, lds, bid, nb)); grid.sync();
    PH(ph_inproj(q, lds, bid, nb)); grid.sync();
    PH(ph_attn(q, (char*)lds_raw, bid, nb)); grid.sync();
    PH(ph_combine(q, bid, nb)); grid.sync();
    PH(ph_outproj(q, lds, bid, nb)); grid.sync();
    PH(ph_route(q, bid, nb)); grid.sync();
    PH(ph_moe1(q, lds, bid, nb)); grid.sync();
    PH(ph_moe2(q, lds, bid, nb)); grid.sync();
    PH(ph_combine2(q, bid, nb)); grid.sync();
    PH(ph_gate(q, lds, bid, nb)); grid.sync();
    PH(ph_final(q, bid, nb));
#undef PH
}

extern "C" void kernel_launch(void* const* d_in, const int* in_sizes, int n_in, void* d_out, int out_size, void* d_ws, size_t ws_size, hipStream_t stream) {
    if (n_in != 23 || in_sizes[0] != M * D || out_size != M * D || ws_size < WS_END) {
        fprintf(stderr, "kernel_launch: unexpected shapes (n_in %d in0 %d out %d ws %zu)\n", n_in, n_in > 0 ? in_sizes[0] : -1, out_size, ws_size); return; }
    static int grid_blocks = 0;
    if (!grid_blocks) {
        int dev = 0, cus = 0, per_cu = 0;
        hipGetDevice(&dev);
        hipDeviceGetAttribute(&cus, hipDeviceAttributeMultiprocessorCount, dev);
        hipFuncSetAttribute((const void*)k_mega, hipFuncAttributeMaxDynamicSharedMemorySize, LDS_BYTES);
        hipOccupancyMaxActiveBlocksPerMultiprocessor(&per_cu, k_mega, NT, LDS_BYTES);
        if (per_cu < 1) { fprintf(stderr, "kernel_launch: occupancy query says %d blocks per CU\n", per_cu); per_cu = 1; }
        grid_blocks = cus * per_cu;
    }
    P p{};
    p.x = (const float*)d_in[0]; p.p = (const float*)d_in[1]; p.pos = (const int*)d_in[2]; p.g_attn = (const float*)d_in[3]; p.w_in = (const float*)d_in[4];
    p.lq1 = (const float*)d_in[5]; p.lk1 = (const float*)d_in[6]; p.lq2 = (const float*)d_in[7]; p.lk2 = (const float*)d_in[8]; p.g_subln = (const float*)d_in[9];
    p.b_forget = (const float*)d_in[10]; p.w_out = (const float*)d_in[11]; p.g_moe = (const float*)d_in[12]; p.w_router = (const float*)d_in[13]; p.b_router = (const float*)d_in[14];
    p.w_e1 = (const float*)d_in[15]; p.b_e1 = (const float*)d_in[16]; p.w_e2 = (const float*)d_in[17]; p.b_e2 = (const float*)d_in[18];
    p.g_ple = (const float*)d_in[19]; p.w_gate = (const float*)d_in[20]; p.w_proj = (const float*)d_in[21]; p.g_final = (const float*)d_in[22];
    p.out = (float*)d_out; p.ws = (unsigned char*)d_ws;
    void* args[] = {&p};
    hipError_t e = hipLaunchCooperativeKernel((void*)k_mega, dim3(grid_blocks), dim3(NT), args, LDS_BYTES, stream);
    if (e != hipSuccess) fprintf(stderr, "cooperative launch failed: %s (grid %d)\n", hipGetErrorString(e), grid_blocks);
}
```

```cpp
#include <hip/hip_runtime.h>
#include <hip/hip_cooperative_groups.h>
#include <hip/hip_bf16.h>
#include <cstdio>
#include <cstdint>
namespace cg = cooperative_groups;

constexpr int NB = 8, SEQ = 2048, D = 1024, M = NB * SEQ;
constexpr int INW = 3080, NPROJ = 3072;
constexpr int NE = 32, TOPK = 4, DE = 1024, PLE = 256;
constexpr float EPS = 1e-5f;
constexpr float LOG2E = 1.4426950408889634f;
constexpr float QSCALE = 0.125f * LOG2E;
constexpr float LAMBDA_INIT = 0.2f;
constexpr int NT = 512, NWAVE = 8;

typedef unsigned short bf16;
typedef short bf16x8 __attribute__((ext_vector_type(8)));
typedef float f32x4 __attribute__((ext_vector_type(4)));
typedef float f32x2 __attribute__((ext_vector_type(2)));
typedef unsigned u32x4 __attribute__((ext_vector_type(4)));
typedef unsigned u32x2 __attribute__((ext_vector_type(2)));

constexpr size_t MiB = 1u << 20;
constexpr size_t WS_CTL = 0;
constexpr size_t CTL_ZERO_BYTES = 65536; constexpr int CW_BAR = 4096;
constexpr size_t WS_COS = 1 * MiB;
constexpr size_t WS_SIN = WS_COS + 512 * 1024;
constexpr size_t WS_LOGF = 2 * MiB;
constexpr size_t WS_CUM = WS_LOGF + 512 * 1024;
constexpr size_t WS_GATE = 3 * MiB;
constexpr size_t WS_WRT = 3 * MiB + 512 * 1024;
constexpr size_t WS_BCNT = 3 * MiB + 768 * 1024;
constexpr size_t WS_SS = 6 * MiB;
constexpr size_t WS_LIST = 4 * MiB;
constexpr size_t WS_XN = 8 * MiB;
constexpr size_t WS_PROJ = 40 * MiB;
constexpr size_t WS_OATT = 136 * MiB;
constexpr size_t WS_MIXED = 184 * MiB;
constexpr size_t WS_H1 = 216 * MiB;
constexpr size_t WS_PP = 280 * MiB;
constexpr size_t WS_ACT = 312 * MiB;
constexpr size_t WS_Y = 456 * MiB;
constexpr size_t WS_H2 = 584 * MiB;
constexpr size_t WS_WIN_T = 648 * MiB;
constexpr size_t WS_WO_T = 654 * MiB;
constexpr size_t WS_WG_T = 656 * MiB;
constexpr size_t WS_WP_T = 658 * MiB;
constexpr size_t WS_PB = 660 * MiB;
constexpr size_t WS_W1_T = 668 * MiB;
constexpr size_t WS_W2_T = 796 * MiB;
constexpr size_t WS_END = 860 * MiB;

constexpr int RING_BYTES = 131072;
constexpr int LDS_TAB = RING_BYTES;
constexpr int LDS_ROWMAP = RING_BYTES + 1024;
constexpr int LDS_MISC = RING_BYTES + 12288;
constexpr int LDS_SEL = RING_BYTES + 12544;
constexpr int LDS_BYTES = 147456;

struct P {
    const float* x; const float* p; const int* pos; const float* g_attn; const float* w_in;
    const float* lq1; const float* lk1; const float* lq2; const float* lk2; const float* g_subln; const float* b_forget;
    const float* w_out; const float* g_moe; const float* w_router; const float* b_router;
    const float* w_e1; const float* b_e1; const float* w_e2; const float* b_e2;
    const float* g_ple; const float* w_gate; const float* w_proj; const float* g_final;
    float* out; unsigned char* ws;
};

__device__ __forceinline__ unsigned f2bf(float f) { unsigned u = __builtin_bit_cast(unsigned, f); return (u + 0x7fffu + ((u >> 16) & 1u)) >> 16; }
__device__ __forceinline__ float bf2f(unsigned h) { return __builtin_bit_cast(float, h << 16); }
__device__ __forceinline__ unsigned pk2(float lo, float hi) { return f2bf(lo) | (f2bf(hi) << 16); }
__device__ __forceinline__ float wave_sum(float v) {
#pragma unroll
    for (int o = 1; o < 64; o <<= 1) v += __shfl_xor(v, o);
    return v;
}
__device__ __forceinline__ int opaque_tid() { int t = threadIdx.x; asm volatile("" : "+v"(t)); return t; }
__device__ __forceinline__ float sigmoidf_(float z) { return 1.0f / (1.0f + __expf(-z)); }

struct SgLds { bf16 a[128][40]; bf16 b[128][40]; };

template <bool A_F32, class RowPtr, class ColMap, class Epi>
__device__ __forceinline__ void sgemm_tile(SgLds& L, RowPtr rowptr, int K, const float* __restrict__ W, int ldw, ColMap colmap, Epi epi) {
    const int tid = opaque_tid(), lane = tid & 63, wid = tid >> 6, wr = wid >> 1, wc = wid & 1, fr = lane & 15, fq = lane >> 4;
    const int ar = tid >> 2, akc = (tid & 3) * 8;
    const void* aptr = rowptr(ar);
    const int bk = tid >> 4, bnc = (tid & 15) * 8;
    int wcol[8];
#pragma unroll
    for (int i = 0; i < 8; ++i) wcol[i] = colmap(bnc + i);
    f32x4 acc[2][4];
#pragma unroll
    for (int m = 0; m < 2; ++m)
#pragma unroll
        for (int n = 0; n < 4; ++n) acc[m][n] = (f32x4){0.f, 0.f, 0.f, 0.f};
    for (int k0 = 0; k0 < K; k0 += 32) {
        u32x4 av = (u32x4){0u, 0u, 0u, 0u};
        if (aptr) {
            if (A_F32) { const float* ap = (const float*)aptr + k0 + akc; const f32x4 v0 = *(const f32x4*)ap, v1 = *(const f32x4*)(ap + 4);
                av.x = pk2(v0.x, v0.y); av.y = pk2(v0.z, v0.w); av.z = pk2(v1.x, v1.y); av.w = pk2(v1.z, v1.w); }
            else av = *(const u32x4*)((const bf16*)aptr + k0 + akc);
        }
        float wv[8];
#pragma unroll
        for (int i = 0; i < 8; ++i) wv[i] = W[(size_t)(k0 + bk) * ldw + wcol[i]];
        __syncthreads();
        *(u32x4*)&L.a[ar][akc] = av;
#pragma unroll
        for (int i = 0; i < 8; ++i) L.b[bnc + i][bk] = (bf16)f2bf(wv[i]);
        __syncthreads();
        bf16x8 af[2], bfr[4];
#pragma unroll
        for (int m = 0; m < 2; ++m) af[m] = *(const bf16x8*)&L.a[wr * 32 + m * 16 + fr][fq * 8];
#pragma unroll
        for (int n = 0; n < 4; ++n) bfr[n] = *(const bf16x8*)&L.b[wc * 64 + n * 16 + fr][fq * 8];
#pragma unroll
        for (int m = 0; m < 2; ++m)
#pragma unroll
            for (int n = 0; n < 4; ++n) acc[m][n] = __builtin_amdgcn_mfma_f32_16x16x32_bf16(af[m], bfr[n], acc[m][n], 0, 0, 0);
    }
    epi(acc, wr, wc, fr, fq);
}

namespace pg8 {
#define PG8_LAS __attribute__((address_space(3)))
constexpr int BM = 256, BK = 64, HALF = 128, HTB = HALF * BK * 2  , STAGE_BYTES = 8 * HTB, NXCD = 8, WGM = 8;

__host__ __device__ __forceinline__ int lds_byte(int r, int c) { const int st = (r >> 4) * 2 + (c >> 5), rr = r & 15, cc = c & 31, ob = rr * 64 + cc * 2; return st * 1024 + (ob ^ (((ob >> 9) & 1) << 5)); }
__host__ __device__ __forceinline__ void stage_rc(int b, int& R, int& C) { const int st = b / 1024, sb = b % 1024, swz = sb ^ (((sb >> 9) & 1) << 5); R = (st >> 1) * 16 + swz / 64; C = (st & 1) * 32 + (swz % 64) / 2; }
__host__ __device__ __forceinline__ int perm32(int rho) { const int n = rho >> 4, i = rho & 15; return 8 * (i >> 2) + 4 * n + (i & 3); }

struct Unit { int pm, pn, e, li; };

struct DenseSched {
    int nM, nN, nwg, G, c, K; const char* A; const char* Bt;
    __device__ void init(const void* A_, const void* Bt_, int M_, int N_, int K_, int G_, int c_) { A = (const char*)A_; Bt = (const char*)Bt_; nM = M_ / BM; nN = N_ / BM; nwg = nM * nN; G = G_; c = c_; K = K_; }
    __device__ bool next(int i, Unit& u) const {
        const long L = (long)i * G + c; if (L >= nwg) return false;
        int wgid = (int)L; { const int q = nwg / NXCD, r = nwg % NXCD, xcd = wgid % NXCD, off = wgid / NXCD; wgid = (xcd < r ? xcd * (q + 1) : r * (q + 1) + (xcd - r) * q) + off; }
        const int nig = WGM * nN, gid = wgid / nig, fm = gid * WGM, gsz = (nM - fm) < WGM ? (nM - fm) : WGM;
        u.pm = fm + ((wgid % nig) % gsz); u.pn = (wgid % nig) / gsz; u.e = 0; u.li = i; return true;
    }
    static constexpr bool GATHER = false;
    __device__ __forceinline__ const char* a_base() const { return A; }
    __device__ __forceinline__ unsigned a_row(const Unit& u, int r) const { return (unsigned)(u.pm * BM + r); }
    __device__ __forceinline__ const char* b_ptr(const Unit& u) const { return Bt + (size_t)u.pn * BM * K * 2; }
};

__device__ __forceinline__ unsigned cvt_pk_bf16(float lo, float hi) { unsigned r; asm volatile("v_cvt_pk_bf16_f32 %0, %1, %2" : "=v"(r) : "v"(lo), "v"(hi)); return r; }
__device__ __forceinline__ float sigm(float z) { return __builtin_amdgcn_rcpf(1.0f + __builtin_amdgcn_exp2f(-LOG2E * z)); }

struct EpiBf16 {
    static constexpr bool PERM = true;
    bf16* O; int ldc;
    __device__ __forceinline__ void operator()(const f32x4 (&acc)[2][2][4][2], const Unit& u, int wr, int wc, int fr, int fq) const {
        const int row0 = u.pm * BM + wr * 64 + fr, col0 = u.pn * BM + wc * 32 + 8 * fq;
#pragma unroll
        for (int ai = 0; ai < 2; ++ai)
#pragma unroll
            for (int m = 0; m < 4; ++m) { bf16* rowp = O + (size_t)(row0 + ai * HALF + m * 16) * ldc + col0;
#pragma unroll
                for (int bj = 0; bj < 2; ++bj) { const f32x4 v0 = acc[ai][bj][m][0], v1 = acc[ai][bj][m][1];
                    u32x4 w; w.x = cvt_pk_bf16(v0[0], v0[1]); w.y = cvt_pk_bf16(v0[2], v0[3]); w.z = cvt_pk_bf16(v1[0], v1[1]); w.w = cvt_pk_bf16(v1[2], v1[3]);
                    *(u32x4*)(rowp + bj * HALF) = w; } }
    }
};
struct EpiInproj {
    static constexpr bool PERM = true;
    bf16* O; const float* COS; const float* SIN;
    __device__ __forceinline__ void operator()(const f32x4 (&acc)[2][2][4][2], const Unit& u, int wr, int wc, int fr, int fq) const {
        const int row0 = u.pm * BM + wr * 64 + fr, colt = u.pn * BM, col0 = colt + wc * 32 + 8 * fq;
        const bool rope = (colt < 1024) && ((wc & 1) == 0);
        const float sc = (colt < 512 || (colt >= 1536 && colt < 2048)) ? QSCALE : 1.0f;
#pragma unroll
        for (int ai = 0; ai < 2; ++ai)
#pragma unroll
            for (int m = 0; m < 4; ++m) {
                const int row = row0 + ai * HALF + m * 16; bf16* rowp = O + (size_t)row * NPROJ + col0;
#pragma unroll
                for (int bj = 0; bj < 2; ++bj) { f32x4 v[2] = {acc[ai][bj][m][0], acc[ai][bj][m][1]};
                    if (rope) {
#pragma unroll
                        for (int n = 0; n < 2; ++n) { const f32x4 c = *(const f32x4*)(COS + (size_t)row * 8 + 4 * n), s = *(const f32x4*)(SIN + (size_t)row * 8 + 4 * n); f32x4 pr;
#pragma unroll
                            for (int i = 0; i < 4; ++i) pr[i] = __shfl_xor(v[n][i], 16);
                            const f32x4 lo = v[n] * c - pr * s, hi = v[n] * c + pr * s;
                            v[n] = (fq == 0) ? lo : (fq == 1) ? hi : v[n]; } }
                    v[0] = v[0] * sc; v[1] = v[1] * sc;
                    u32x4 w; w.x = cvt_pk_bf16(v[0][0], v[0][1]); w.y = cvt_pk_bf16(v[0][2], v[0][3]); w.z = cvt_pk_bf16(v[1][0], v[1][1]); w.w = cvt_pk_bf16(v[1][2], v[1][3]);
                    *(u32x4*)(rowp + bj * HALF) = w; } }
    }
};
struct EpiResF32 {
    static constexpr bool PERM = false;
    const float* base; float* C; int ldc; float* SS;
    __device__ __forceinline__ void operator()(const f32x4 (&acc)[2][2][4][2], const Unit& u, int wr, int wc, int fr, int fq) const {
        const int row0 = u.pm * BM + wr * 64 + fr, col0 = u.pn * BM + wc * 32 + 4 * fq;
#pragma unroll
        for (int ai = 0; ai < 2; ++ai)
#pragma unroll
            for (int m = 0; m < 4; ++m) { const int row = row0 + ai * HALF + m * 16; const size_t off = (size_t)row * ldc + col0; float ss = 0.f;
#pragma unroll
                for (int bj = 0; bj < 2; ++bj)
#pragma unroll
                    for (int n = 0; n < 2; ++n) { const f32x4 v = *(const f32x4*)(base + off + bj * HALF + n * 16) + acc[ai][bj][m][n]; *(f32x4*)(C + off + bj * HALF + n * 16) = v; ss += (v[0] * v[0] + v[1] * v[1]) + (v[2] * v[2] + v[3] * v[3]); }
                ss += __shfl_xor(ss, 16); ss += __shfl_xor(ss, 32);
                if (fq == 0) SS[(size_t)row * 16 + u.pn * 4 + wc] = ss; }
    }
};
struct EpiGate {
    static constexpr bool PERM = false;
    const float* H2; const bf16* PP; float* C; int ldc;
    __device__ __forceinline__ void operator()(const f32x4 (&acc)[2][2][4][2], const Unit& u, int wr, int wc, int fr, int fq) const {
        const int row0 = u.pm * BM + wr * 64 + fr, col0 = u.pn * BM + wc * 32 + 4 * fq;
#pragma unroll
        for (int ai = 0; ai < 2; ++ai)
#pragma unroll
            for (int m = 0; m < 4; ++m) { const size_t off = (size_t)(row0 + ai * HALF + m * 16) * ldc + col0;
#pragma unroll
                for (int bj = 0; bj < 2; ++bj)
#pragma unroll
                    for (int n = 0; n < 2; ++n) { const size_t o = off + bj * HALF + n * 16; const u32x2 pw = *(const u32x2*)(PP + o); const f32x4 a = acc[ai][bj][m][n];
                        f32x4 r = *(const f32x4*)(H2 + o);
                        r[0] += sigm(a[0]) * __builtin_bit_cast(float, pw.x << 16); r[1] += sigm(a[1]) * __builtin_bit_cast(float, pw.x & 0xffff0000u);
                        r[2] += sigm(a[2]) * __builtin_bit_cast(float, pw.y << 16); r[3] += sigm(a[3]) * __builtin_bit_cast(float, pw.y & 0xffff0000u);
                        *(f32x4*)(C + o) = r; } }
    }
};

struct MoeTab { int tstart[33]; int rbase[32]; int cnt[32]; int mt[32]; };
static_assert(sizeof(MoeTab) <= 1024, "MoeTab must fit below the row maps");
template <int MODE  > struct MoeSched {
    static constexpr bool GATHER = (MODE == 1);
    const PG8_LAS MoeTab* T; const PG8_LAS int* rowmap; int nN, G, c, K; const char* A; const char* Bt; size_t bstride;
    __device__ bool next(int i, Unit& u) const {
        const int nwg = __builtin_amdgcn_readfirstlane(T->tstart[32]); const long L = (long)i * G + c; if (L >= nwg) return false;
        int wgid = (int)L; { const int q = nwg / NXCD, r = nwg % NXCD, xcd = wgid % NXCD, off = wgid / NXCD; wgid = (xcd < r ? xcd * (q + 1) : r * (q + 1) + (xcd - r) * q) + off; }
        int e = 0;
        for (int j = 1; j < 32; ++j) e = (wgid >= T->tstart[j]) ? j : e;
        e = __builtin_amdgcn_readfirstlane(e);
        const int r = wgid - __builtin_amdgcn_readfirstlane(T->tstart[e]), mt = __builtin_amdgcn_readfirstlane(T->mt[e]);
        u.e = e; u.pm = r % mt; u.pn = r / mt; u.li = i; return true;
    }
    __device__ __forceinline__ const char* a_base() const { return A; }
    __device__ __forceinline__ unsigned a_row(const Unit& u, int r) const { return MODE == 1 ? (unsigned)rowmap[u.li * 256 + r] : (unsigned)(__builtin_amdgcn_readfirstlane(T->rbase[u.e]) + u.pm * BM + r); }
    __device__ __forceinline__ const char* b_ptr(const Unit& u) const { return Bt + (size_t)u.e * bstride + (size_t)u.pn * BM * K * 2; }
};
__device__ __forceinline__ float swiglu(float g, float l) { const float glu = fminf(g, 7.0f), lin = fminf(fmaxf(l, -7.0f), 7.0f); return glu * sigm(1.702f * glu) * (lin + 1.0f); }
struct EpiMoe1 {
    static constexpr bool PERM = true;
    bf16* ACT; const float* B1; const PG8_LAS MoeTab* T;
    __device__ __forceinline__ void operator()(const f32x4 (&acc)[2][2][4][2], const Unit& u, int wr, int wc, int fr, int fq) const {
        const int row0 = T->rbase[u.e] + u.pm * BM + wr * 64 + fr, acol0 = u.pn * 128 + wc * 16 + 4 * fq;
        const float* bp = B1 + (size_t)u.e * 2 * DE + u.pn * BM + wc * 32 + 8 * fq;
        f32x4 bv[2][2];
#pragma unroll
        for (int bj = 0; bj < 2; ++bj)
#pragma unroll
            for (int n = 0; n < 2; ++n) bv[bj][n] = *(const f32x4*)(bp + bj * HALF + 4 * n);
#pragma unroll
        for (int ai = 0; ai < 2; ++ai)
#pragma unroll
            for (int m = 0; m < 4; ++m) { bf16* rowp = ACT + (size_t)(row0 + ai * HALF + m * 16) * DE + acol0;
#pragma unroll
                for (int bj = 0; bj < 2; ++bj) { const f32x4 v0 = acc[ai][bj][m][0] + bv[bj][0], v1 = acc[ai][bj][m][1] + bv[bj][1];
                    u32x2 w; w.x = cvt_pk_bf16(swiglu(v0[0], v0[1]), swiglu(v0[2], v0[3])); w.y = cvt_pk_bf16(swiglu(v1[0], v1[1]), swiglu(v1[2], v1[3]));
                    *(u32x2*)(rowp + bj * 64) = w; } }
    }
};
struct EpiMoe2 {
    static constexpr bool PERM = true;
    bf16* Y; const float* B2; const PG8_LAS int* rowmap;
    __device__ __forceinline__ void operator()(const f32x4 (&acc)[2][2][4][2], const Unit& u, int wr, int wc, int fr, int fq) const {
        const int col0 = u.pn * BM + wc * 32 + 8 * fq;
        const float* bp = B2 + (size_t)u.e * D + col0;
        f32x4 bv[2][2];
#pragma unroll
        for (int bj = 0; bj < 2; ++bj)
#pragma unroll
            for (int n = 0; n < 2; ++n) bv[bj][n] = *(const f32x4*)(bp + bj * HALF + 4 * n);
#pragma unroll
        for (int ai = 0; ai < 2; ++ai)
#pragma unroll
            for (int m = 0; m < 4; ++m) { const int slot = rowmap[u.li * 256 + ai * HALF + wr * 64 + m * 16 + fr];
                if (slot >= 0) { bf16* rowp = Y + (size_t)slot * D + col0;
#pragma unroll
                    for (int bj = 0; bj < 2; ++bj) { const f32x4 v0 = acc[ai][bj][m][0] + bv[bj][0], v1 = acc[ai][bj][m][1] + bv[bj][1];
                        u32x4 w; w.x = cvt_pk_bf16(v0[0], v0[1]); w.y = cvt_pk_bf16(v0[2], v0[3]); w.z = cvt_pk_bf16(v1[0], v1[1]); w.w = cvt_pk_bf16(v1[2], v1[3]);
                        *(u32x4*)(rowp + bj * HALF) = w; } } }
    }
};

template <class Epi, class Sched, bool ALIGN_EPI>
__device__ __forceinline__ void gemm_phase(PG8_LAS unsigned char* lds, const int K, const Sched& S, const Epi& E) {
    constexpr bool GA = Sched::GATHER;
    int tid_ = opaque_tid();
    const int tid = tid_, wid = __builtin_amdgcn_readfirstlane(tid >> 6), lane = tid & 63, wr = wid >> 2, wc = wid & 3, fr = lane & 15, fq = lane >> 4;
    const int nt = K / BK;
    unsigned voffA[2], voffB[2];
#pragma unroll
    for (int i = 0; i < 2; ++i) { int R, C; stage_rc(tid * 16 + i * 8192, R, C); const int Rb = Epi::PERM ? ((R & ~31) + perm32(R & 31)) : R;
        voffA[i] = (unsigned)(R * K + C) * 2u; voffB[i] = (unsigned)(Rb * K + C) * 2u; }
    const size_t kstep = (size_t)(BK * 2);
    const size_t hstep = (size_t)HALF * K * 2;
    const unsigned ldsw = (unsigned)wid * 1024u;
    const int aoff = lds_byte(wr * 64 + fr, fq * 8), boff = lds_byte(wc * 32 + fr, fq * 8);
    const char* const Ab = S.a_base();
#define PG8_SA(b, h) (((b) * 2 + (h)) * HTB)
#define PG8_SB(b, h) ((4 + (b) * 2 + (h)) * HTB)
#define PG8_STAGE(bufoff, gbase, voff) do { _Pragma("unroll") for (int _i = 0; _i < 2; ++_i) \
        __builtin_amdgcn_global_load_lds((const unsigned*)((const char*)(gbase) + (voff)[_i]), (PG8_LAS unsigned*)(lds + (bufoff) + ldsw + _i * 8192), 16, 0, 0); } while (0)
#define PG8_STAGE_A(bufoff, up, vp, h, ko) do { if constexpr (GA) PG8_STAGE(bufoff, Ab + (ko), (vp)[h]); else PG8_STAGE(bufoff, (up) + (h) * hstep + (ko), voffA); } while (0)
#define PG8_LDA(dst, b, h) do { _Pragma("unroll") for (int m = 0; m < 4; ++m) _Pragma("unroll") for (int k = 0; k < 2; ++k) dst[m][k] = *(const PG8_LAS bf16x8*)(lds + PG8_SA(b, h) + aoff + m * 2048 + k * 1024); } while (0)
#define PG8_LDB(dst, b, h) do { _Pragma("unroll") for (int n = 0; n < 2; ++n) _Pragma("unroll") for (int k = 0; k < 2; ++k) dst[n][k] = *(const PG8_LAS bf16x8*)(lds + PG8_SB(b, h) + boff + n * 2048 + k * 1024); } while (0)
#define PG8_MMA(ai, bj, At, Bt) do { __builtin_amdgcn_s_setprio(1); _Pragma("unroll") for (int m = 0; m < 4; ++m) _Pragma("unroll") for (int n = 0; n < 2; ++n) _Pragma("unroll") for (int k = 0; k < 2; ++k) \
        acc[ai][bj][m][n] = __builtin_amdgcn_mfma_f32_16x16x32_bf16(Bt[n][k], At[m][k], acc[ai][bj][m][n], 0, 0, 0); __builtin_amdgcn_s_setprio(0); } while (0)
#define PG8_WAIT_V(n) asm volatile("s_waitcnt vmcnt(" #n ")" ::: "memory")
#define PG8_WAIT_L(n) asm volatile("s_waitcnt lgkmcnt(" #n ")" ::: "memory")
#define PG8_BAR __builtin_amdgcn_s_barrier()
#define PG8_SCHED __builtin_amdgcn_sched_barrier(0)
#define PG8_AOFF(dst, u) do { if constexpr (GA) { _Pragma("unroll") for (int _h = 0; _h < 2; ++_h) _Pragma("unroll") for (int _i = 0; _i < 2; ++_i) { int R_, C_; stage_rc(tid * 16 + _i * 8192, R_, C_); \
        dst[_h][_i] = S.a_row(u, _h * HALF + R_) * (unsigned)(K * 2) + (unsigned)C_ * 2u; } } } while (0)
    Unit cur, nxt; int ui = 0;
    if (!S.next(0, cur)) return;
    f32x4 acc[2][2][4][2];
#pragma unroll
    for (int a = 0; a < 2; ++a)
#pragma unroll
        for (int b = 0; b < 2; ++b)
#pragma unroll
            for (int m = 0; m < 4; ++m)
#pragma unroll
                for (int n = 0; n < 2; ++n) acc[a][b][m][n] = (f32x4){0.f, 0.f, 0.f, 0.f};
    bf16x8 At[4][2], B0[2][2], B1[2][2];
    unsigned vAc[2][2];
    PG8_AOFF(vAc, cur);
    const char* cA = GA ? Ab : Ab + (size_t)S.a_row(cur, 0) * K * 2;
    const char* cB = S.b_ptr(cur);
    PG8_STAGE(PG8_SB(0, 0), cB, voffB); PG8_STAGE(PG8_SB(0, 1), cB + hstep, voffB); PG8_STAGE_A(PG8_SA(0, 0), cA, vAc, 0, 0); PG8_STAGE_A(PG8_SA(0, 1), cA, vAc, 1, 0);
    if (wr == 1) PG8_BAR;
    PG8_WAIT_V(2); PG8_BAR;
    PG8_STAGE(PG8_SB(1, 0), cB + kstep, voffB); PG8_STAGE_A(PG8_SA(1, 0), cA, vAc, 0, kstep); PG8_STAGE(PG8_SB(1, 1), cB + hstep + kstep, voffB);
    PG8_WAIT_V(6); PG8_BAR;
    for (;;) {
        const bool has_next = S.next(ui + 1, nxt);
        const char* nB = cB; const char* nA = cA;
        if (has_next) { nB = S.b_ptr(nxt); if constexpr (!GA) nA = Ab + (size_t)S.a_row(nxt, 0) * K * 2; }
        for (int t = 0; t < nt; t += 2) {
            const bool last = (t == nt - 2);
            const size_t k1 = (size_t)(t + 1) * kstep, k2 = last ? 0 : (size_t)(t + 2) * kstep, k3 = k2 + kstep;
            const char* a2 = last ? nA : cA; const char* b2 = last ? nB : cB + (size_t)(t + 2) * kstep; const char* b3 = b2 + kstep;
            unsigned v2[2][2];
            if constexpr (GA) {
                if (last && has_next) PG8_AOFF(v2, nxt);
                else {
#pragma unroll
                    for (int h = 0; h < 2; ++h)
#pragma unroll
                        for (int i = 0; i < 2; ++i) v2[h][i] = vAc[h][i];
                }
            }
            PG8_LDB(B0, 0, 0); PG8_LDB(B1, 0, 1); PG8_SCHED; PG8_LDA(At, 0, 0); PG8_STAGE_A(PG8_SA(1, 1), cA, vAc, 1, k1);
            PG8_WAIT_V(8); PG8_WAIT_L(0); PG8_BAR; PG8_MMA(0, 0, At, B0); PG8_MMA(0, 1, At, B1); PG8_BAR; PG8_SCHED;
            PG8_LDA(At, 0, 1); PG8_STAGE(PG8_SB(0, 0), b2, voffB); PG8_STAGE(PG8_SB(0, 1), b2 + hstep, voffB); PG8_STAGE_A(PG8_SA(0, 0), a2, v2, 0, k2);
            PG8_WAIT_V(8); PG8_WAIT_L(0); PG8_BAR; PG8_MMA(1, 0, At, B0); PG8_MMA(1, 1, At, B1); PG8_BAR; PG8_SCHED;
            PG8_LDB(B0, 1, 0); PG8_LDB(B1, 1, 1); PG8_SCHED; PG8_LDA(At, 1, 0); PG8_STAGE_A(PG8_SA(0, 1), a2, v2, 1, k2);
            PG8_WAIT_V(8); PG8_WAIT_L(0); PG8_BAR; PG8_MMA(0, 0, At, B0); PG8_MMA(0, 1, At, B1); PG8_BAR; PG8_SCHED;
            PG8_LDA(At, 1, 1); PG8_STAGE(PG8_SB(1, 0), b3, voffB); PG8_STAGE(PG8_SB(1, 1), b3 + hstep, voffB); PG8_STAGE_A(PG8_SA(1, 0), a2, v2, 0, k3);
            PG8_WAIT_V(8); PG8_WAIT_L(0); PG8_BAR; PG8_MMA(1, 0, At, B0); PG8_MMA(1, 1, At, B1); PG8_BAR; PG8_SCHED;
        }
        if constexpr (ALIGN_EPI) { if (wr == 0) PG8_BAR; }
        E(acc, cur, wr, wc, fr, fq);
        if (!has_next) break;
#pragma unroll
        for (int a = 0; a < 2; ++a)
#pragma unroll
            for (int b = 0; b < 2; ++b)
#pragma unroll
                for (int m = 0; m < 4; ++m)
#pragma unroll
                    for (int n = 0; n < 2; ++n) acc[a][b][m][n] = (f32x4){0.f, 0.f, 0.f, 0.f};
        cur = nxt; cA = nA; cB = nB; ++ui;
        PG8_AOFF(vAc, cur);
        if constexpr (ALIGN_EPI) { if (wr == 1) PG8_BAR; }
    }
    PG8_WAIT_V(0);
    if constexpr (!ALIGN_EPI) { if (wr == 0) PG8_BAR; }
    PG8_BAR;
#undef PG8_SA
#undef PG8_SB
#undef PG8_STAGE
#undef PG8_STAGE_A
#undef PG8_LDA
#undef PG8_LDB
#undef PG8_MMA
#undef PG8_WAIT_V
#undef PG8_WAIT_L
#undef PG8_BAR
#undef PG8_SCHED
#undef PG8_AOFF
}
}

namespace attn_body {
using bf16=__hip_bfloat16;
using bf16x8=__attribute__((ext_vector_type(8)))short;
using s16x4=__attribute__((ext_vector_type(4)))short;
using f32x16=__attribute__((ext_vector_type(16)))float;
using u32x4=__attribute__((ext_vector_type(4)))unsigned;
constexpr int SEQ=2048,D=64,PQ=3072,PO=1024;
constexpr int NW=8,QBLK=32,QB=QBLK*NW,KVBLK=64,NQB=SEQ/QB;
constexpr int ATTN_UNIT_ROWS=QB;
__device__ __forceinline__ int crow(int r,int hi){return (r&3)+8*(r>>2)+4*hi;}
#define SBAR() __builtin_amdgcn_sched_barrier(0)
__device__ __forceinline__ void cmask(f32x16&p0,f32x16&p1,int jb,int qrel,int hi){
  const float NEG=-INFINITY; int kb=64*jb+4*hi;
  #pragma unroll
  for(int r=0;r<16;++r){int kv=kb+(r&3)+8*(r>>2); if(kv>qrel)p0[r]=NEG; if(kv+32>qrel)p1[r]=NEG;}
}

constexpr int NSLOT=3, SLOTB=8192;
constexpr int LDS_K=0, LDS_V=NSLOT*SLOTB, LDS_WS=2*NSLOT*SLOTB, LDS_OST=LDS_WS+NW*64*4, LDS_BIAS=LDS_OST+NW*4096, LDS_BYTES=LDS_BIAS+SEQ*4;
constexpr float C2=0.125f*1.4426950408889634f;
__device__ __forceinline__ void glds16(const void*gsrc,unsigned lds_dst){unsigned keep;
  asm volatile("s_mov_b32 %0, m0\n\ts_mov_b32 m0, %2\n\ts_nop 0\n\tglobal_load_lds_dwordx4 %1, off\n\ts_mov_b32 m0, %0":"=&s"(keep):"v"(gsrc),"s"(lds_dst):"memory");}
__device__ __forceinline__ float max3f(float a,float b,float c){float r;asm("v_max3_f32 %0, %1, %2, %3":"=v"(r):"v"(a),"v"(b),"v"(c));return r;}
__device__ __forceinline__ float max2f(float a,float b){float r;asm("v_max_f32_e32 %0, %1, %2":"=v"(r):"v"(a),"v"(b));return r;}
__device__ __forceinline__ float fadd_s(float a,float b){float r;asm("v_add_f32_e32 %0, %1, %2":"=v"(r):"v"(a),"v"(b));return r;}
__device__ __forceinline__ float fsub_s(float a,float b){float r;asm("v_sub_f32_e32 %0, %1, %2":"=v"(r):"v"(a),"v"(b));return r;}
typedef float f32x4_t __attribute__((ext_vector_type(4))); typedef float f32x2_t __attribute__((ext_vector_type(2))); typedef __bf16 bf16x2_t __attribute__((ext_vector_type(2)));
__device__ __forceinline__ unsigned cvtpk_s(float lo,float hi){f32x2_t v={lo,hi};bf16x2_t b=__builtin_convertvector(v,bf16x2_t);return __builtin_bit_cast(unsigned,b);}
#define WAIT_BAR(N) asm volatile("s_waitcnt vmcnt(" #N ") lgkmcnt(0)\n\ts_barrier":::"memory")

__device__ __forceinline__ void qkt(f32x16&p0,f32x16&p1,const char*Kslot,const bf16x8*qr,const f32x16&negm,int r32,int hi){
  const char*kb=Kslot+hi*1024+r32*16;
  #pragma unroll
  for(int d0=0;d0<4;++d0){
    const bf16x8 b0=*reinterpret_cast<const bf16x8*>(kb+d0*2048);
    const bf16x8 b1=*reinterpret_cast<const bf16x8*>(kb+d0*2048+512);
    if(d0==0){p0=__builtin_amdgcn_mfma_f32_32x32x16_bf16(b0,qr[0],negm,0,0,0);p1=__builtin_amdgcn_mfma_f32_32x32x16_bf16(b1,qr[0],negm,0,0,0);}
    else{p0=__builtin_amdgcn_mfma_f32_32x32x16_bf16(b0,qr[d0],p0,0,0,0);p1=__builtin_amdgcn_mfma_f32_32x32x16_bf16(b1,qr[d0],p1,0,0,0);}}
}
typedef __attribute__((address_space(3))) const char* lds_cptr;
typedef short v4i16_t __attribute__((ext_vector_type(4)));
__device__ __forceinline__ void kload8(bf16x8*kf,lds_cptr kp){
  kf[0]=*(const __attribute__((address_space(3))) bf16x8*)(kp);      kf[1]=*(const __attribute__((address_space(3))) bf16x8*)(kp+512);
  kf[2]=*(const __attribute__((address_space(3))) bf16x8*)(kp+2048); kf[3]=*(const __attribute__((address_space(3))) bf16x8*)(kp+2560);
  kf[4]=*(const __attribute__((address_space(3))) bf16x8*)(kp+4096); kf[5]=*(const __attribute__((address_space(3))) bf16x8*)(kp+4608);
  kf[6]=*(const __attribute__((address_space(3))) bf16x8*)(kp+6144); kf[7]=*(const __attribute__((address_space(3))) bf16x8*)(kp+6656);
}
__device__ __forceinline__ void kload2(bf16x8*kf,lds_cptr kp,int j){ kf[2*j]=*(const __attribute__((address_space(3))) bf16x8*)(kp+j*2048); kf[2*j+1]=*(const __attribute__((address_space(3))) bf16x8*)(kp+j*2048+512); }
__device__ __forceinline__ s16x4 vtr(lds_cptr p){ return __builtin_bit_cast(s16x4,__builtin_amdgcn_ds_read_tr16_b64_v4i16((__attribute__((address_space(3))) v4i16_t*)p)); }
__device__ __forceinline__ float rowmax(const f32x16&p0,const f32x16&p1){
  float a=max3f(p0[0],p0[1],p1[0]),b=max3f(p0[2],p0[3],p1[1]);a=max3f(a,p1[2],p1[3]);
  #pragma unroll
  for(int r=4;r<16;r+=4){a=max3f(a,p0[r],p0[r+1]);b=max3f(b,p0[r+2],p0[r+3]);a=max3f(a,p1[r],p1[r+1]);b=max3f(b,p1[r+2],p1[r+3]);}
  const float m=max2f(a,b);
  auto rr=__builtin_amdgcn_permlane32_swap(__float_as_uint(m),__float_as_uint(m),false,false);
  return max2f(__uint_as_float(rr[0]),__uint_as_float(rr[1]));
}
__device__ __forceinline__ void pv(f32x16*o,int vb,bf16x8 pa0,bf16x8 pa1,bf16x8 pa2,bf16x8 pa3){
  #pragma unroll
  for(int d0=0;d0<2;++d0){s16x4 lo[4],hi[4];
    #pragma unroll
    for(int ks=0;ks<4;++ks){
      asm volatile("ds_read_b64_tr_b16 %0,%1 offset:%c2":"=&v"(lo[ks]):"v"(vb),"i"(d0*4096+ks*1024):"memory");
      asm volatile("ds_read_b64_tr_b16 %0,%1 offset:%c2":"=&v"(hi[ks]):"v"(vb),"i"(d0*4096+ks*1024+512):"memory");}
    asm volatile("s_waitcnt lgkmcnt(0)":::"memory");SBAR();
    #define PK(k) (bf16x8){lo[k][0],lo[k][1],lo[k][2],lo[k][3],hi[k][0],hi[k][1],hi[k][2],hi[k][3]}
    o[d0]=__builtin_amdgcn_mfma_f32_32x32x16_bf16(pa0,PK(0),o[d0],0,0,0);
    o[d0]=__builtin_amdgcn_mfma_f32_32x32x16_bf16(pa1,PK(1),o[d0],0,0,0);
    o[d0]=__builtin_amdgcn_mfma_f32_32x32x16_bf16(pa2,PK(2),o[d0],0,0,0);
    o[d0]=__builtin_amdgcn_mfma_f32_32x32x16_bf16(pa3,PK(3),o[d0],0,0,0);
    #undef PK
  }
}

#ifndef ATTN_STORE16
#define ATTN_STORE16(p,v) (*(u32x4*)(p)=(v))
#endif
template<int THRL,bool FOX> __device__ __forceinline__ void attn_unit(int b,int qb,int qcol,int kcol,int vcol,int ocol,const bf16*Q,const bf16*__restrict__ K,const bf16*__restrict__ V,bf16*O,const float*__restrict__ CB,char*shm){
  int tid_=threadIdx.x; asm volatile("":"+v"(tid_));
  const int tid=tid_,lane=tid&63,r32=lane&31,hi=lane>>5; const int wid=__builtin_amdgcn_readfirstlane(tid>>6);
  const long rowbase=(long)b*SEQ; const int q0=qb*QB;
  const bf16*Qw=Q+(rowbase+q0+wid*QBLK)*PQ+qcol;
  const bf16*Kh=K+rowbase*PQ+kcol,*Vh=V+rowbase*PQ+vcol;
  const unsigned lds0=(unsigned)(uintptr_t)shm;
  float*wsf=(float*)(shm+LDS_WS)+wid*64;
  const bf16*ksrc=Kh+(long)lane*PQ+wid*8;
  const bf16*vsrc=Vh+(long)(16*(wid&3)+(lane>>2))*PQ+(wid>>2)*32+(lane&3)*8;
  const unsigned kdst=lds0+LDS_K+wid*1024, vdst=lds0+LDS_V+wid*1024;
  #define DMA_K(t,slot) glds16(ksrc+(long)(t)*KVBLK*PQ,(unsigned)__builtin_amdgcn_readfirstlane(kdst+(slot)))
  #define DMA_V(t,slot) glds16(vsrc+(long)(t)*KVBLK*PQ,(unsigned)__builtin_amdgcn_readfirstlane(vdst+(slot)))
  const int vb0=(int)(lds0+LDS_V)+((lane>>4)&1)*32+(lane&3)*8+(4*hi+((lane&15)>>2))*64;
  const char*Kbase=shm+LDS_K; bf16x8 kf[8];
  const lds_cptr shm3=(lds_cptr)shm; const lds_cptr kp0=shm3+LDS_K+hi*1024+r32*16; const lds_cptr vp0=shm3+LDS_V+((lane>>4)&1)*32+(lane&3)*8+(4*hi+((lane&15)>>2))*64;
  const int NT=(q0+QB)/KVBLK;
  if(FOX){ float*bl=(float*)(shm+LDS_BIAS); for(int i=tid;i<(q0+QB)/4;i+=NW*64)((f32x4_t*)bl)[i]=((const f32x4_t*)CB)[i]; asm volatile("s_waitcnt vmcnt(0) lgkmcnt(0)":::"memory"); }
  const lds_cptr bp0=(lds_cptr)shm+LDS_BIAS+hi*16;
  DMA_K(0,0);DMA_V(0,0);DMA_K(1,SLOTB);
  bf16x8 qr[4];
  #pragma unroll
  for(int d0=0;d0<4;++d0)qr[d0]=*reinterpret_cast<const bf16x8*>(&Qw[(long)r32*PQ+d0*16+hi*8]);
  float mhat=0.f,l_reg=0.f;f32x16 o[2];o[0]=f32x16{};o[1]=f32x16{};float z0_;asm volatile("v_mov_b32 %0, 0":"=v"(z0_));f32x16 negm;_Pragma("unroll") for(int r=0;r<16;++r)negm[r]=z0_;asm volatile("":"+v"(negm));
  const int qrel=wid*QBLK+r32;
  #define CMASK(P0,P1,t) do{int jb_=(t)-(NT-4); if(jb_>=0)cmask(P0,P1,jb_,qrel,hi);}while(0)
  #define BIASADD(P0,P1,t) do{ if(FOX){ const lds_cptr bq_=bp0+(t)*256; _Pragma("unroll") for(int g_=0;g_<4;++g_){ const f32x4_t b0_=*(const __attribute__((address_space(3))) f32x4_t*)(bq_+g_*32), b1_=*(const __attribute__((address_space(3))) f32x4_t*)(bq_+g_*32+128); \
      _Pragma("unroll") for(int e_=0;e_<4;++e_){ P0[4*g_+e_]+=b0_[e_]; P1[4*g_+e_]+=b1_[e_]; } } } }while(0)
  bool resc=false;
  #define START(P0,P1) do{ const float rm=rowmax(P0,P1); resc=false; \
    { const float dl=rm; mhat=fadd_s(mhat,dl); \
      _Pragma("unroll") for(int r=0;r<16;++r){P0[r]=fsub_s(P0[r],dl);P1[r]=fsub_s(P1[r],dl);} \
      _Pragma("unroll") for(int r=0;r<16;++r)negm[r]=-mhat; asm volatile("":"+v"(negm)); } \
    _Pragma("unroll") for(int r=0;r<16;++r)P0[r]=__builtin_amdgcn_exp2f(P0[r]); }while(0)
  #define RESC() do{ if(resc){ asm volatile("s_waitcnt lgkmcnt(0)":::"memory"); \
      _Pragma("unroll") for(int d_=0;d_<2;++d_) _Pragma("unroll") for(int r=0;r<16;++r)o[d_][r]*=wsf[crow(r,hi)]; } }while(0)
  f32x16 pA0,pA1,pB0,pB1;
  int sl_prev=0,sl_cur=0,sl_next=SLOTB;
  #define ROT() do{sl_prev=sl_cur;sl_cur=sl_next;sl_next=(sl_next==(NSLOT-1)*SLOTB)?0:sl_next+SLOTB;}while(0)
  DMA_K(2,2*SLOTB);
  WAIT_BAR(3);
  qkt(pA0,pA1,Kbase,qr,negm,r32,hi);asm volatile("s_nop 15\n\ts_nop 7":"+v"(pA0),"+v"(pA1));BIASADD(pA0,pA1,0);CMASK(pA0,pA1,0);
  START(pA0,pA1);
  _Pragma("unroll") for(int r=0;r<16;++r)pA1[r]=__builtin_amdgcn_exp2f(pA1[r]);
  WAIT_BAR(0);
  DMA_K(3,0);DMA_V(1,SLOTB);
  ROT();
  kload8(kf,kp0+sl_cur);
  WAIT_BAR(2);
  s16x4 vlo[8],vhi[8]; u32x4 pw0,pw1,pw2,pw3;
  #define PKW(P,B) cvtpk_s(P[B],P[B+1])
  #define PAF(k) __builtin_bit_cast(bf16x8,pw##k)
  #define VFR(i) (bf16x8){vlo[i][0],vlo[i][1],vlo[i][2],vlo[i][3],vhi[i][0],vhi[i][1],vhi[i][2],vhi[i][3]}
  #define PIN(x) asm volatile("":"+v"(x))
  #define MX3(a,b,c) __builtin_fmaxf(__builtin_fmaxf((a),(b)),(c))
  #define GAPA(MF,A0,A1,A2,A3,W0,W1,PW) do{ MF; sacc+=A0; sacc+=A1; sacc+=A2; sacc+=A3; PIN(sacc); W0; W1; PIN(PW); SBAR(); }while(0)
  #define EX(v) __builtin_amdgcn_exp2f(v)
  #define GAPB(MF,X,B) do{ MF; X[B]=EX(X[B]); X[B+1]=EX(X[B+1]); X[B+2]=EX(X[B+2]); X[B+3]=EX(X[B+3]); PIN(X); SBAR(); }while(0)
  #define VRD(i) do{ vlo[i]=vtr(vp_+(((i)>>2)*4096+((i)&3)*1024)); vhi[i]=vtr(vp_+(((i)>>2)*4096+((i)&3)*1024+512)); }while(0)
  #define KRD(G,j) do{ if(G){ kload2(kf,kp0+sl_next,j); SBAR(); } }while(0)
  #define STEP(C0,C1,P0,P1,t,GK,GV,GL) do{ SBAR(); \
    const lds_cptr vp_=vp0+sl_prev; \
    VRD(0); SBAR(); float sacc=(P0[0]+P0[1]); \
    GAPA(C0=__builtin_amdgcn_mfma_f32_32x32x16_bf16(kf[0],qr[0],negm,0,0,0), P0[2],P0[3],P0[4],P0[5],     pw0[0]=PKW(P0,0), pw0[1]=PKW(P0,2), pw0); \
    VRD(4); SBAR(); GAPA(C1=__builtin_amdgcn_mfma_f32_32x32x16_bf16(kf[1],qr[0],negm,0,0,0), P0[6],P0[7],P0[8],P0[9],     pw0[2]=PKW(P0,4), pw0[3]=PKW(P0,6), pw0); \
    VRD(1); SBAR(); GAPA(C0=__builtin_amdgcn_mfma_f32_32x32x16_bf16(kf[2],qr[1],C0,0,0,0),   P0[10],P0[11],P0[12],P0[13], pw1[0]=PKW(P0,8), pw1[1]=PKW(P0,10), pw1); \
    VRD(5); SBAR(); GAPA(C1=__builtin_amdgcn_mfma_f32_32x32x16_bf16(kf[3],qr[1],C1,0,0,0),   P0[14],P0[15],P1[0],P1[1],   pw1[2]=PKW(P0,12),pw1[3]=PKW(P0,14), pw1); \
    VRD(2); SBAR(); GAPA(C0=__builtin_amdgcn_mfma_f32_32x32x16_bf16(kf[4],qr[2],C0,0,0,0),   P1[2],P1[3],P1[4],P1[5],     pw2[0]=PKW(P1,0), pw2[1]=PKW(P1,2), pw2); \
    VRD(6); SBAR(); GAPA(C1=__builtin_amdgcn_mfma_f32_32x32x16_bf16(kf[5],qr[2],C1,0,0,0),   P1[6],P1[7],P1[8],P1[9],     pw2[2]=PKW(P1,4), pw2[3]=PKW(P1,6), pw2); \
    VRD(3); SBAR(); GAPA(C0=__builtin_amdgcn_mfma_f32_32x32x16_bf16(kf[6],qr[3],C0,0,0,0),   P1[10],P1[11],P1[12],P1[13], pw3[0]=PKW(P1,8), pw3[1]=PKW(P1,10), pw3); \
    VRD(7); SBAR(); GAPA(C1=__builtin_amdgcn_mfma_f32_32x32x16_bf16(kf[7],qr[3],C1,0,0,0),   P1[14],P1[15],0.f,0.f,       pw3[2]=PKW(P1,12),pw3[3]=PKW(P1,14), pw3); \
    l_reg+=sacc; \
    if(GK){DMA_K((t)+3,sl_cur);} if(GV){DMA_V((t)+1,sl_next);} \
    BIASADD(C0,C1,t); CMASK(C0,C1,t); \
    { float a=MX3(C0[0],C0[1],C1[0]),b=MX3(C0[2],C0[3],C1[1]); a=MX3(a,C1[2],C1[3]); \
      _Pragma("unroll") for(int r=4;r<16;r+=4){a=MX3(a,C0[r],C0[r+1]);b=MX3(b,C0[r+2],C0[r+3]);a=MX3(a,C1[r],C1[r+1]);b=MX3(b,C1[r+2],C1[r+3]);} \
      float rm=__builtin_fmaxf(a,b); { auto rr=__builtin_amdgcn_permlane32_swap(__float_as_uint(rm),__float_as_uint(rm),false,false); rm=__builtin_fmaxf(__uint_as_float(rr[0]),__uint_as_float(rr[1])); } \
      resc=false; \
      if(__builtin_expect(__any(rm>(float)THRL),0)){ const float dl=__builtin_fmaxf(rm,0.f); mhat+=dl; \
        _Pragma("unroll") for(int r=0;r<16;++r){C0[r]-=dl;C1[r]-=dl;} \
        _Pragma("unroll") for(int r=0;r<16;++r)negm[r]=-mhat; asm volatile("":"+v"(negm)); \
        const float f=__builtin_amdgcn_exp2f(-dl); l_reg*=f; if(hi==0)wsf[r32]=f; resc=true; } } \
    SBAR(); \
    GAPB(o[0]=__builtin_amdgcn_mfma_f32_32x32x16_bf16(PAF(0),VFR(0),o[0],0,0,0), C0,0); \
    GAPB(o[1]=__builtin_amdgcn_mfma_f32_32x32x16_bf16(PAF(0),VFR(4),o[1],0,0,0), C0,4); \
    KRD(GL,0); GAPB(o[0]=__builtin_amdgcn_mfma_f32_32x32x16_bf16(PAF(1),VFR(1),o[0],0,0,0), C0,8); \
    KRD(GL,1); GAPB(o[1]=__builtin_amdgcn_mfma_f32_32x32x16_bf16(PAF(1),VFR(5),o[1],0,0,0), C0,12); \
    KRD(GL,2); GAPB(o[0]=__builtin_amdgcn_mfma_f32_32x32x16_bf16(PAF(2),VFR(2),o[0],0,0,0), C1,0); \
    KRD(GL,3); GAPB(o[1]=__builtin_amdgcn_mfma_f32_32x32x16_bf16(PAF(2),VFR(6),o[1],0,0,0), C1,4); \
    GAPB(o[0]=__builtin_amdgcn_mfma_f32_32x32x16_bf16(PAF(3),VFR(3),o[0],0,0,0), C1,8); \
    GAPB(o[1]=__builtin_amdgcn_mfma_f32_32x32x16_bf16(PAF(3),VFR(7),o[1],0,0,0), C1,12); \
    }while(0)
  int t=1;
  #undef CMASK
  #define CMASK(P0,P1,t) do{}while(0)
  for(;t+5<NT;t+=2){
    STEP(pB0,pB1,pA0,pA1,t,true,true,true);     WAIT_BAR(2); RESC(); ROT();
    STEP(pA0,pA1,pB0,pB1,t+1,true,true,true);   WAIT_BAR(2); RESC(); ROT();
  }
  #undef CMASK
  #define CMASK(P0,P1,t) do{int jb_=(t)-(NT-4); if(jb_>=0)cmask(P0,P1,jb_,qrel,hi);}while(0)
  #define ENDW(tt) do{ if((tt)+3<NT){WAIT_BAR(2);} else if((tt)+2<NT){WAIT_BAR(1);} else {WAIT_BAR(0);} }while(0)
  for(;t+1<NT;t+=2){
    STEP(pB0,pB1,pA0,pA1,t,(t+3<NT),(t+1<NT),(t+1<NT));       ENDW(t);   RESC(); ROT();
    STEP(pA0,pA1,pB0,pB1,t+1,(t+4<NT),(t+2<NT),(t+2<NT));     ENDW(t+1); RESC(); ROT();
  }
  STEP(pB0,pB1,pA0,pA1,NT-1,false,false,false); RESC();
  { float sacc=pB0[0]+pB0[1]; _Pragma("unroll") for(int r=2;r<16;++r)sacc+=pB0[r]; _Pragma("unroll") for(int r=0;r<16;++r)sacc+=pB1[r]; l_reg+=sacc;
    pw0=(u32x4){PKW(pB0,0),PKW(pB0,2),PKW(pB0,4),PKW(pB0,6)};pw1=(u32x4){PKW(pB0,8),PKW(pB0,10),PKW(pB0,12),PKW(pB0,14)};pw2=(u32x4){PKW(pB1,0),PKW(pB1,2),PKW(pB1,4),PKW(pB1,6)};pw3=(u32x4){PKW(pB1,8),PKW(pB1,10),PKW(pB1,12),PKW(pB1,14)};
    SBAR(); pv(o,vb0+sl_cur,PAF(0),PAF(1),PAF(2),PAF(3)); }
  #undef PKW
  #undef PAF
  #undef VFR
  #undef PIN
  #undef MX3
  #undef GAPA
  #undef GAPB
  #undef EX
  #undef VRD
  #undef KRD
  #undef STEP
  #undef ENDW
  {auto rr=__builtin_amdgcn_permlane32_swap(__float_as_uint(l_reg),__float_as_uint(l_reg),false,false);l_reg=__uint_as_float(rr[0])+__uint_as_float(rr[1]);}
  if(hi==0)wsf[32+r32]=l_reg;asm volatile("s_waitcnt lgkmcnt(0)":::"memory");
  float rli[16];
  #pragma unroll
  for(int r=0;r<16;++r)rli[r]=__builtin_amdgcn_rcpf(wsf[32+crow(r,hi)]);
  bf16*Ow=O+(rowbase+q0+wid*QBLK)*PO+ocol;
  { bf16*stg=(bf16*)(shm+LDS_OST)+wid*2048;
    #pragma unroll
    for(int r=0;r<16;++r){const int orow=crow(r,hi);
      #pragma unroll
      for(int d0=0;d0<2;++d0)stg[orow*64+d0*32+r32]=__float2bfloat16(o[d0][r]*rli[r]);}
    asm volatile("s_waitcnt lgkmcnt(0)":::"memory");
    #pragma unroll
    for(int i=0;i<4;++i){const int row=i*8+(lane>>3),ch=lane&7; const u32x4 v=*(const u32x4*)(stg+row*64+ch*8); ATTN_STORE16(Ow+(long)row*PO+ch*8,v);} }
  asm volatile("s_waitcnt lgkmcnt(0)\n\ts_barrier":::"memory");
  #undef DMA_K
  #undef DMA_V
  #undef CMASK
  #undef BIASADD
  #undef START
  #undef RESC
  #undef ROT
}
constexpr int ATTN_LDS_BYTES=LDS_BYTES;
#undef SBAR
#undef WAIT_BAR
}
#define LAS __attribute__((address_space(3)))
#define XB_TMO      128
#define XB_XCNT(j)  (256  + 64 * (j))
#define XB_XSUB(j)  (1280 + 64 * (j))
#define XB_XGEN(j)  (2304 + 64 * (j))
#define XB_TOP      3328
#define XB_TOPGEN   3392
#define XCD_BAR_WORDS 3456
#define XB_SPIN_CAP (1u << 18)

__device__ __forceinline__ unsigned xb_ld(unsigned* p)              { return __hip_atomic_load(p, __ATOMIC_RELAXED, __HIP_MEMORY_SCOPE_AGENT); }
__device__ __forceinline__ unsigned xb_add(unsigned* p, unsigned v) { return __hip_atomic_fetch_add(p, v, __ATOMIC_RELAXED, __HIP_MEMORY_SCOPE_AGENT); }
__device__ __forceinline__ unsigned xb_xcc_id() { return (unsigned)__builtin_amdgcn_s_getreg((3 << 11) | 20) & 0xFu; }
#define XB_SPIN(cond, bar) do { unsigned _sp = 0; while (cond) { __builtin_amdgcn_s_sleep(1); \
    if ((++_sp & 255u) == 0u) { if (xb_ld(&(bar)[XB_TMO])) break; if (_sp > XB_SPIN_CAP) { atomicAdd(&(bar)[XB_TMO], 1u); break; } } } } while (0)

struct XcdBarrier {
    unsigned* bar; unsigned x;
    volatile LAS unsigned* st;
};

__device__ __forceinline__ XcdBarrier xcd_barrier_post(unsigned* bar, volatile LAS unsigned* st) {
    XcdBarrier b; b.bar = bar; b.x = xb_xcc_id(); b.st = st;
    if (threadIdx.x == 0) (void)xb_add(&bar[XB_XCNT(b.x)], 1u);
    return b;
}
__device__ __forceinline__ void xcd_barrier_complete(unsigned* bar, unsigned x, unsigned& nloc, unsigned& nx) {
    const unsigned G = gridDim.x * gridDim.y * gridDim.z;
    unsigned sum, cnt, mine, sp = 0u;
    for (;;) {
        sum = 0u; cnt = 0u; mine = 0u;
#pragma unroll
        for (unsigned j = 0; j < 16; ++j) { const unsigned c = xb_ld(&bar[XB_XCNT(j)]); sum += c; cnt += (c > 0u) ? 1u : 0u; mine = (j == x) ? c : mine; }
        if (sum == G) break;
        __builtin_amdgcn_s_sleep(1);
        if ((++sp & 255u) == 0u) { if (xb_ld(&bar[XB_TMO])) break; if (sp > XB_SPIN_CAP) { atomicAdd(&bar[XB_TMO], 1u); break; } }
    }
    nloc = mine > 0u ? mine : 1u; nx = cnt > 0u ? cnt : 1u;
}

__device__ __forceinline__ void xcd_barrier(const XcdBarrier& b) {
    asm volatile("s_waitcnt vmcnt(0)" ::: "memory");
    __syncthreads();
    if (threadIdx.x == 0) {
        unsigned* bar = b.bar;
        __builtin_amdgcn_s_waitcnt(0);
        unsigned nloc = b.st[0], nx = b.st[1];
        if (nloc == 0u) { xcd_barrier_complete(bar, b.x, nloc, nx); b.st[0] = nloc; b.st[1] = nx; }
        const unsigned old = xb_add(&bar[XB_XSUB(b.x)], 1u);
        const unsigned gen = old / nloc;
        if (old + 1u == (gen + 1u) * nloc) {
            __builtin_amdgcn_fence(__ATOMIC_RELEASE, "agent");
            asm volatile("s_waitcnt vmcnt(0)" ::: "memory");
            const unsigned og = xb_add(&bar[XB_TOP], 1u);
            const unsigned tg = og / nx;
            if (og + 1u == (tg + 1u) * nx) xb_add(&bar[XB_TOPGEN], 1u);
            else XB_SPIN(xb_ld(&bar[XB_TOPGEN]) == tg, bar);
            __builtin_amdgcn_fence(__ATOMIC_ACQUIRE, "agent");
            xb_add(&bar[XB_XGEN(b.x)], 1u);
            asm volatile("s_waitcnt vmcnt(0)" ::: "memory");
        } else {
            XB_SPIN(xb_ld(&bar[XB_XGEN(b.x)]) == gen, bar);
            __builtin_amdgcn_fence(__ATOMIC_ACQUIRE, "agent");
            asm volatile("s_waitcnt vmcnt(0)" ::: "memory");
        }
    }
    __syncthreads();
}


__device__ __forceinline__ void transpose_item(const float* __restrict__ W, int K, int ldw, int ncols, bf16* __restrict__ WT, LAS unsigned char* scr, int item, int lane) {
    const int nblk = ncols / 64, kb = item / nblk, nb = item % nblk, k0 = 64 * kb, n0 = 64 * nb;
    const float* src = W + (size_t)(k0 + (lane >> 4)) * ldw + n0;
#pragma unroll
    for (int j = 0; j < 16; ++j) { const int k = 4 * j + (lane >> 4), cg = ((lane & 15) + (k >> 3)) & 15;
        __builtin_amdgcn_global_load_lds((const unsigned*)(src + (size_t)(4 * j) * ldw + cg * 4), (LAS unsigned*)(scr + j * 1024), 16, 0, 0); }
    asm volatile("s_waitcnt vmcnt(0)" ::: "memory");
    const int k8 = lane & 7; const LAS float* sp = (const LAS float*)scr + (k8 * 8) * 64;
#pragma unroll
    for (int i = 0; i < 8; ++i) { const int nl = (lane >> 3) + 8 * i, c = ((nl >> 2) - k8) & 15; const LAS float* q = sp + c * 4 + (nl & 3);
        u32x4 o; o.x = pk2(q[0 * 64], q[1 * 64]); o.y = pk2(q[2 * 64], q[3 * 64]); o.z = pk2(q[4 * 64], q[5 * 64]); o.w = pk2(q[6 * 64], q[7 * 64]);
        *(u32x4*)(WT + (size_t)(n0 + nl) * K + k0 + 8 * k8) = o; }
    asm volatile("s_waitcnt lgkmcnt(0)" ::: "memory");
}
__device__ __forceinline__ void ph_prologue(const P& p, LAS unsigned char* lds, int bid, int nb) {
    const int tid = opaque_tid(), lane = tid & 63, wave = __builtin_amdgcn_readfirstlane(tid >> 6);
    const int gw = bid * NWAVE + wave, ngw = nb * NWAVE;
    for (int i = bid * NT + tid; i < NE * D; i += nb * NT) { const int e = i >> 10, k = i & 1023; const float w = p.w_router[(size_t)k * NE + e]; const unsigned h = f2bf(w);
        ((bf16*)(p.ws + WS_WRT))[i] = (bf16)h; ((bf16*)(p.ws + WS_WRT))[NE * D + i] = (bf16)f2bf(w - bf2f(h)); }
    {
        LAS unsigned char* scr = lds + wave * 16384;
        constexpr int I_IN = (D / 64) * (NPROJ / 64), I_O = (D / 64) * (D / 64), I_G = I_O, I_P = (PLE / 64) * (D / 64);
        constexpr int I_E1 = (D / 64) * (2 * DE / 64), I_E2 = (DE / 64) * (D / 64);
        constexpr int NITEMS = I_IN + I_O + I_G + I_P + NE * (I_E1 + I_E2);
        for (int it = gw; it < NITEMS; it += ngw) {
            int r = it;
            if (r < I_IN) { transpose_item(p.w_in, D, INW, NPROJ, (bf16*)(p.ws + WS_WIN_T), scr, r, lane); continue; } r -= I_IN;
            if (r < I_O) { transpose_item(p.w_out, D, D, D, (bf16*)(p.ws + WS_WO_T), scr, r, lane); continue; } r -= I_O;
            if (r < I_G) { transpose_item(p.w_gate, D, D, D, (bf16*)(p.ws + WS_WG_T), scr, r, lane); continue; } r -= I_G;
            if (r < I_P) { transpose_item(p.w_proj, PLE, D, D, (bf16*)(p.ws + WS_WP_T), scr, r, lane); continue; } r -= I_P;
            const int e = r / (I_E1 + I_E2); r -= e * (I_E1 + I_E2);
            if (r < I_E1) transpose_item(p.w_e1 + (size_t)e * D * 2 * DE, D, 2 * DE, 2 * DE, (bf16*)(p.ws + WS_W1_T) + (size_t)e * 2 * DE * D, scr, r, lane);
            else transpose_item(p.w_e2 + (size_t)e * DE * D, DE, D, D, (bf16*)(p.ws + WS_W2_T) + (size_t)e * D * DE, scr, r - I_E1, lane);
        }
    }
}
__device__ __forceinline__ void ph_prologue_rows(const P& p, LAS unsigned char* lds, int bid, int nb) {
    const int tid = opaque_tid(), lane = tid & 63, wave = __builtin_amdgcn_readfirstlane(tid >> 6);
    const int gw = bid * NWAVE + wave, ngw = nb * NWAVE;
    bf16* XN = (bf16*)(p.ws + WS_XN); bf16* PB = (bf16*)(p.ws + WS_PB);
    float* LOGF = (float*)(p.ws + WS_LOGF); float* COS = (float*)(p.ws + WS_COS); float* SIN = (float*)(p.ws + WS_SIN);
    for (int idx = (bid * NT + tid); idx < M * 8; idx += nb * NT) {
        const int m = idx >> 3, i = idx & 7;
        const double invf = exp2(-(double)i * 0.125 * 18.931568569324174);
        const double ang = (double)p.pos[m] * invf;
        const double kq = rint(ang * 0.15915494309189535);
        const float rf = (float)((ang - kq * 6.283185307179586) - kq * 2.4492935982947064e-16);
        COS[idx] = cosf(rf); SIN[idx] = sinf(rf);
    }
    LAS float* wz = (LAS float*)lds;
    __syncthreads();
    for (int i = tid; i < D * 8; i += NT) { const int k = i >> 3, c = i & 7; wz[c * D + k] = p.w_in[(size_t)k * INW + NPROJ + c]; }
    __syncthreads();
    for (int m = gw; m < M; m += ngw) {
        const f32x4* xr = (const f32x4*)(p.x + (size_t)m * D) + lane;
        f32x4 v[4]; float ss = 0.f;
#pragma unroll
        for (int j = 0; j < 4; ++j) { v[j] = xr[64 * j]; ss += (v[j].x * v[j].x + v[j].y * v[j].y) + (v[j].z * v[j].z + v[j].w * v[j].w); }
        { const f32x4 pv = ((const f32x4*)(p.p + (size_t)m * PLE))[lane]; u32x2 o; o.x = pk2(pv.x, pv.y); o.y = pk2(pv.z, pv.w); ((u32x2*)(PB + (size_t)m * PLE))[lane] = o; }
        const float rstd = 1.0f / sqrtf(wave_sum(ss) * (1.f / D) + EPS);
        float fz[8];
#pragma unroll
        for (int i = 0; i < 8; ++i) fz[i] = 0.f;
#pragma unroll
        for (int j = 0; j < 4; ++j) {
            const f32x4 g = ((const f32x4*)p.g_attn)[lane + 64 * j];
            v[j] = v[j] * rstd * g;
#pragma unroll
            for (int i = 0; i < 8; ++i) { const f32x4 w = *(const LAS f32x4*)(wz + i * D + 4 * lane + 256 * j); fz[i] += (v[j].x * w.x + v[j].y * w.y) + (v[j].z * w.z + v[j].w * w.w); }
            u32x2 o; o.x = pk2(v[j].x, v[j].y); o.y = pk2(v[j].z, v[j].w);
            *((u32x2*)(XN + (size_t)m * D) + lane + 64 * j) = o;
        }
#pragma unroll
        for (int i = 0; i < 8; ++i) fz[i] = wave_sum(fz[i]);
        if (lane < 8) {
            float z = 0.f;
#pragma unroll
            for (int i = 0; i < 8; ++i) z = (lane == i) ? fz[i] : z;
            z += p.b_forget[lane];
            LOGF[(size_t)m * 8 + lane] = fminf(z, 0.f) - log1pf(__expf(-fabsf(z)));
        }
    }
    __syncthreads();
}

__device__ __forceinline__ void ph_inproj(const P& p, LAS unsigned char* lds, int bid, int nb) {
    const int tid = opaque_tid(), lane = tid & 63, wave = tid >> 6;
    {
        const int gw = bid * NWAVE + wave;
        if (gw < NB * 8) {
            const int b = gw >> 3, h = gw & 7;
            const float* LOGF = (const float*)(p.ws + WS_LOGF); float* CB = (float*)(p.ws + WS_CUM) + (size_t)gw * SEQ;
            float loc[32]; float s = 0.f;
#pragma unroll
            for (int i = 0; i < 32; ++i) { s += LOGF[(size_t)(b * SEQ + lane * 32 + i) * 8 + h]; loc[i] = s; }
            float inc = s;
#pragma unroll
            for (int o = 1; o < 64; o <<= 1) { const float t = __shfl_up(inc, o); if (lane >= o) inc += t; }
            const float excl = inc - s;
#pragma unroll
            for (int i = 0; i < 32; ++i) CB[lane * 32 + i] = -(excl + loc[i]) * LOG2E;
        }
        asm volatile("s_waitcnt vmcnt(0)" ::: "memory"); __syncthreads();
    }
    {
        pg8::DenseSched S; S.init(p.ws + WS_XN, p.ws + WS_WIN_T, M, NPROJ, D, nb, bid);
        pg8::EpiInproj E{(bf16*)(p.ws + WS_PROJ), (const float*)(p.ws + WS_COS), (const float*)(p.ws + WS_SIN)};
        pg8::gemm_phase<pg8::EpiInproj, pg8::DenseSched, true>(lds, D, S, E);
    }
    {
        pg8::DenseSched S; S.init(p.ws + WS_PB, p.ws + WS_WP_T, M, D, PLE, nb, bid);
        pg8::EpiBf16 E{(bf16*)(p.ws + WS_PP), D};
        pg8::gemm_phase<pg8::EpiBf16, pg8::DenseSched, true>(lds, PLE, S, E);
    }
}

struct AUnit { int b, qb, qcol, kcol, vcol, ocol, cb; };
struct FoxOrder {
    int vcu, nb;
    __device__ __forceinline__ bool next(int i, AUnit& u) const {
        const int fp = vcu + (i >> 1) * nb; if (fp >= 256) return false;
        const int hf = (fp >> 2) & 7, s = fp & 3;
        u.b = fp >> 5; u.qb = (i & 1) ? 7 - s : s; u.qcol = 1536 + hf * 64; u.kcol = 2048 + hf * 64; u.vcol = 2560 + hf * 64; u.ocol = 512 + hf * 64; u.cb = u.b * 8 + hf; return true;
    }
};
struct DiffOrder {
    int vcu, nb;
    __device__ __forceinline__ bool next(int i, AUnit& u) const {
        const int v = vcu + (i >> 2) * nb; if (2 * v >= 512) return false;
        const int dp = 2 * v + ((i >> 1) & 1), pr = (dp >> 2) & 15, s = dp & 3, h = pr >> 2, mm = (pr >> 1) & 1, vh = pr & 1;
        u.b = dp >> 6; u.qb = (i & 1) ? 7 - s : s; u.qcol = h * 128 + mm * 64; u.kcol = 512 + u.qcol; u.vcol = 1024 + h * 128 + vh * 64; u.ocol = mm * 512 + h * 128 + vh * 64; u.cb = 0; return true;
    }
};
__device__ __forceinline__ void ph_attn(const P& p, char* shm, int bid, int nb) {
    typedef attn_body::bf16 abf;
    const int vcu = (nb % 8 == 0) ? (bid % 8) * (nb / 8) + bid / 8 : bid;
    const abf* PROJ = (const abf*)(p.ws + WS_PROJ); const float* CB = (const float*)(p.ws + WS_CUM);
    AUnit u;
    { const FoxOrder S{vcu, nb};
      for (int i = 0; S.next(i, u); ++i) attn_body::attn_unit<8, true>(u.b, u.qb, u.qcol, u.kcol, u.vcol, u.ocol, PROJ, PROJ, PROJ, (abf*)(p.ws + WS_MIXED), CB + (size_t)u.cb * SEQ, shm); }
    { const DiffOrder S{vcu, nb};
      for (int i = 0; S.next(i, u); ++i) attn_body::attn_unit<8, false>(u.b, u.qb, u.qcol, u.kcol, u.vcol, u.ocol, PROJ, PROJ, PROJ, (abf*)(p.ws + WS_OATT), nullptr, shm); }
}

__device__ void ph_combine(const P& p, int bid, int nb) {
    const int tid = opaque_tid(), lane = tid & 63, wave = tid >> 6;
    const int gw = bid * NWAVE + wave, ngw = nb * NWAVE;
    const float lam = __expf(wave_sum(p.lq1[lane] * p.lk1[lane])) - __expf(wave_sum(p.lq2[lane] * p.lk2[lane])) + LAMBDA_INIT;
    const bf16* OATT = (const bf16*)(p.ws + WS_OATT); bf16* MIXED = (bf16*)(p.ws + WS_MIXED);
    const float g0 = p.g_subln[2 * lane], g1 = p.g_subln[2 * lane + 1];
    for (int m = gw; m < M; m += ngw) {
#pragma unroll
        for (int h = 0; h < 4; ++h) {
            const unsigned a = *(const unsigned*)(OATT + (size_t)m * D + h * 128 + 2 * lane), c = *(const unsigned*)(OATT + (size_t)m * D + 512 + h * 128 + 2 * lane);
            const float d0 = bf2f(a & 0xffffu) - lam * bf2f(c & 0xffffu), d1 = bf2f(a >> 16) - lam * bf2f(c >> 16);
            const float rstd = 1.0f / sqrtf(wave_sum(d0 * d0 + d1 * d1) * (1.f / 128.f) + EPS);
            *(unsigned*)(MIXED + (size_t)m * D + h * 128 + 2 * lane) = pk2(d0 * rstd * g0 * (1.f - LAMBDA_INIT), d1 * rstd * g1 * (1.f - LAMBDA_INIT));
        }
    }
}

__device__ __forceinline__ void ph_outproj(const P& p, LAS unsigned char* lds, int bid, int nb) {
    pg8::DenseSched S; S.init(p.ws + WS_MIXED, p.ws + WS_WO_T, M, D, D, nb, bid);
    pg8::EpiResF32 E{p.x, (float*)(p.ws + WS_H1), D, (float*)(p.ws + WS_SS)};
    pg8::gemm_phase<pg8::EpiResF32, pg8::DenseSched, true>(lds, D, S, E);
}

typedef float f32x16 __attribute__((ext_vector_type(16)));
__device__ __forceinline__ void ph_route(const P& p, LAS unsigned char* lds, int bid, int nb) {
    const int tid = opaque_tid(), lane = tid & 63, wave = __builtin_amdgcn_readfirstlane(tid >> 6), r32 = lane & 31, hi = lane >> 5;
    const float* H1 = (const float*)(p.ws + WS_H1); const float* SS = (const float*)(p.ws + WS_SS); bf16* XN = (bf16*)(p.ws + WS_XN);
    const bf16* WH = (const bf16*)(p.ws + WS_WRT); const bf16* WL = WH + NE * D;
    float* GATE = (float*)(p.ws + WS_GATE);
    LAS unsigned* lcnt = (LAS unsigned*)(lds + LDS_SEL); LAS unsigned* sel = lcnt + 64;
    if (tid < 32) lcnt[tid] = 0u;
    __syncthreads();
    LAS float* rs = (LAS float*)lds;
    LAS unsigned char* xs = lds + 1024 + wave * 10240;
    LAS float* part = (LAS float*)(lds + 1024 + 8 * 10240);
    LAS float* lgs = part + 8 * 32 * 33;
    constexpr int XP = 144;
    int li = 0;
    for (int it = bid; it < M / 32; it += nb, ++li) {
        const int tok0 = it * 32;
        { const int row = tid >> 4, part_ = tid & 15; float s = SS[(size_t)(tok0 + row) * 16 + part_];
          s += __shfl_xor(s, 1); s += __shfl_xor(s, 2); s += __shfl_xor(s, 4); s += __shfl_xor(s, 8);
          if (part_ == 0) rs[row] = 1.0f / sqrtf(s * (1.f / D) + EPS); }
        __syncthreads();
        f32x16 acc;
#pragma unroll
        for (int r = 0; r < 16; ++r) acc[r] = 0.f;
#pragma unroll
        for (int ch = 0; ch < 2; ++ch) {
            const int k0 = wave * 128 + ch * 64;
            const f32x4 g = *(const f32x4*)(p.g_moe + k0 + (lane & 15) * 4);
#pragma unroll
            for (int i8 = 0; i8 < 8; ++i8) {
                const int row = i8 * 4 + (lane >> 4), kq = (lane & 15) * 4;
                const f32x4 h = *(const f32x4*)(H1 + (size_t)(tok0 + row) * D + k0 + kq);
                const float r_ = rs[row];
                const f32x4 y = h * r_ * g;
                const unsigned h0 = f2bf(y[0]), h1 = f2bf(y[1]), h2 = f2bf(y[2]), h3 = f2bf(y[3]);
                u32x2 wh; wh.x = h0 | (h1 << 16); wh.y = h2 | (h3 << 16);
                u32x2 wl; wl.x = pk2(y[0] - bf2f(h0), y[1] - bf2f(h1)); wl.y = pk2(y[2] - bf2f(h2), y[3] - bf2f(h3));
                *(u32x2*)(XN + (size_t)(tok0 + row) * D + k0 + kq) = wh;
                *(LAS u32x2*)(xs + row * XP + kq * 2) = wh; *(LAS u32x2*)(xs + 32 * XP + row * XP + kq * 2) = wl;
            }
            asm volatile("s_waitcnt lgkmcnt(0)" ::: "memory");
#pragma unroll
            for (int ks = 0; ks < 4; ++ks) {
                const bf16x8 xh = *(const LAS bf16x8*)(xs + r32 * XP + ks * 32 + hi * 16), xl = *(const LAS bf16x8*)(xs + 32 * XP + r32 * XP + ks * 32 + hi * 16);
                const bf16x8 wh = *(const bf16x8*)(WH + (size_t)r32 * D + k0 + ks * 16 + hi * 8), wl = *(const bf16x8*)(WL + (size_t)r32 * D + k0 + ks * 16 + hi * 8);
                acc = __builtin_amdgcn_mfma_f32_32x32x16_bf16(wh, xh, acc, 0, 0, 0);
                acc = __builtin_amdgcn_mfma_f32_32x32x16_bf16(wl, xh, acc, 0, 0, 0);
                acc = __builtin_amdgcn_mfma_f32_32x32x16_bf16(wh, xl, acc, 0, 0, 0);
            }
            asm volatile("s_waitcnt lgkmcnt(0)" ::: "memory");
        }
#pragma unroll
        for (int r = 0; r < 16; ++r) part[(wave * 32 + (r & 3) + 8 * (r >> 2) + 4 * hi) * 33 + r32] = acc[r];
        __syncthreads();
#pragma unroll
        for (int q = 0; q < 2; ++q) { const int idx = tid + q * NT, e = idx >> 5, t = idx & 31; float s = p.b_router[e];
#pragma unroll
            for (int w = 0; w < 8; ++w) s += part[(w * 32 + e) * 33 + t];
            lgs[t * 33 + e] = s; }
        __syncthreads();
        if (tid < 32) {
            const int m = tok0 + tid; float lg[32];
#pragma unroll
            for (int e = 0; e < 32; ++e) lg[e] = lgs[tid * 33 + e];
            int idx[4]; float val[4];
#pragma unroll
            for (int k = 0; k < 4; ++k) {
                float best = -INFINITY; int bi = 0;
#pragma unroll
                for (int e = 0; e < 32; ++e) { const bool take = lg[e] > best; best = take ? lg[e] : best; bi = take ? e : bi; }
                idx[k] = bi; val[k] = best;
#pragma unroll
                for (int e = 0; e < 32; ++e) lg[e] = (e == bi) ? -INFINITY : lg[e];
            }
            const float e1 = __expf(val[1] - val[0]), e2 = __expf(val[2] - val[0]), e3 = __expf(val[3] - val[0]);
            const float rsum = 1.f / (1.f + e1 + e2 + e3);
            f32x4 gt; gt[0] = rsum; gt[1] = e1 * rsum; gt[2] = e2 * rsum; gt[3] = e3 * rsum;
            *(f32x4*)(GATE + (size_t)m * 4) = gt;
#pragma unroll
            for (int k = 0; k < 4; ++k) { const unsigned lp = atomicAdd((unsigned*)&lcnt[idx[k]], 1u); sel[li * 128 + tid * 4 + k] = (unsigned)idx[k] | (lp << 8); }
        }
        __syncthreads();
    }
    if (tid < 32) ((unsigned*)(p.ws + WS_BCNT))[bid * 32 + tid] = lcnt[tid];
}
__device__ __forceinline__ void ph_route2(const P& p, LAS unsigned char* lds, int bid, int nb) {
    const int tid = opaque_tid();
    const unsigned* BCNT = (const unsigned*)(p.ws + WS_BCNT); unsigned* CNT = (unsigned*)(p.ws + WS_CTL); int* LIST = (int*)(p.ws + WS_LIST);
    LAS unsigned* lcnt = (LAS unsigned*)(lds + LDS_SEL); LAS unsigned* lbase = lcnt + 32; LAS unsigned* sel = lcnt + 64; LAS unsigned* red = (LAS unsigned*)lds;
    { const int e = tid & 31, part = tid >> 5; unsigned s = 0;
      for (int b = part; b < bid; b += 16) s += BCNT[b * 32 + e];
      red[part * 32 + e] = s; }
    __syncthreads();
    if (tid < 32) { unsigned s = 0;
#pragma unroll
        for (int q = 0; q < 16; ++q) s += red[q * 32 + tid];
        lbase[tid] = s; if (bid == nb - 1) CNT[tid] = s + lcnt[tid]; }
    __syncthreads();
    int li = 0;
    for (int it = bid; it < M / 32; it += nb, ++li)
        if (tid < 128) { const unsigned v = sel[li * 128 + tid], e = v & 255u, lp = v >> 8; LIST[e * M + lbase[e] + lp] = it * 128 + tid; }
}

template <int MODE> __device__ __forceinline__ void moe_setup(const P& p, LAS unsigned char* lds, int nN, int bid, int nb) {
    const int tid = opaque_tid();
    LAS pg8::MoeTab* T = (LAS pg8::MoeTab*)(lds + LDS_TAB); LAS int* rowmap = (LAS int*)(lds + LDS_ROWMAP);
    const unsigned* CNT = (const unsigned*)(p.ws + WS_CTL); const int* LIST = (const int*)(p.ws + WS_LIST);
    if (tid == 0) { int ts = 0, rb = 0;
        for (int e = 0; e < NE; ++e) { const int c = (int)CNT[e], mt = (c + 255) >> 8; T->tstart[e] = ts; T->rbase[e] = rb; T->cnt[e] = c; T->mt[e] = mt; ts += mt * nN; rb += mt * 256; }
        T->tstart[32] = ts; }
    __syncthreads();
    pg8::MoeSched<MODE> S{T, rowmap, nN, nb, bid, 0, nullptr, nullptr, 0};
    pg8::Unit u;
    for (int i = 0; i < 9 && S.next(i, u); ++i)
        if (tid < 256) { const int rr = u.pm * 256 + tid; const int v = rr < T->cnt[u.e] ? LIST[u.e * M + rr] : -1; rowmap[i * 256 + tid] = MODE == 1 ? (v < 0 ? 0 : (v >> 2)) : v; }
    __syncthreads();
}
__device__ __forceinline__ void ph_moe1(const P& p, LAS unsigned char* lds, int bid, int nb) {
    moe_setup<1>(p, lds, 8, bid, nb);
    const LAS pg8::MoeTab* T = (const LAS pg8::MoeTab*)(lds + LDS_TAB); const LAS int* rowmap = (const LAS int*)(lds + LDS_ROWMAP);
    pg8::MoeSched<1> S{T, rowmap, 8, nb, bid, D, (const char*)(p.ws + WS_XN), (const char*)(p.ws + WS_W1_T), (size_t)2 * DE * D * 2};
    pg8::EpiMoe1 E{(bf16*)(p.ws + WS_ACT), p.b_e1, T};
    pg8::gemm_phase<pg8::EpiMoe1, pg8::MoeSched<1>, true>(lds, D, S, E);
}
__device__ __forceinline__ void ph_moe2(const P& p, LAS unsigned char* lds, int bid, int nb) {
    moe_setup<2>(p, lds, 4, bid, nb);
    const LAS pg8::MoeTab* T = (const LAS pg8::MoeTab*)(lds + LDS_TAB); const LAS int* rowmap = (const LAS int*)(lds + LDS_ROWMAP);
    pg8::MoeSched<2> S{T, rowmap, 4, nb, bid, DE, (const char*)(p.ws + WS_ACT), (const char*)(p.ws + WS_W2_T), (size_t)D * DE * 2};
    pg8::EpiMoe2 E{(bf16*)(p.ws + WS_Y), p.b_e2, rowmap};
    pg8::gemm_phase<pg8::EpiMoe2, pg8::MoeSched<2>, true>(lds, DE, S, E);
}

__device__ void ph_combine2(const P& p, int bid, int nb) {
    const int tid = opaque_tid(), lane = tid & 63, wave = tid >> 6;
    const int gw = bid * NWAVE + wave, ngw = nb * NWAVE;
    const float* H1 = (const float*)(p.ws + WS_H1); float* H2 = (float*)(p.ws + WS_H2); bf16* XN = (bf16*)(p.ws + WS_XN);
    const bf16* Y = (const bf16*)(p.ws + WS_Y); const float* GATE = (const float*)(p.ws + WS_GATE);
    for (int m = gw; m < M; m += ngw) {
        const f32x4 gt = *(const f32x4*)(GATE + (size_t)m * 4);
        f32x4 v[4]; float ss = 0.f;
#pragma unroll
        for (int j = 0; j < 4; ++j) {
            v[j] = ((const f32x4*)(H1 + (size_t)m * D))[lane + 64 * j];
#pragma unroll
            for (int k = 0; k < 4; ++k) {
                const u32x2 w = *((const u32x2*)(Y + (size_t)(m * 4 + k) * D) + lane + 64 * j);
                const float g = gt[k];
                v[j].x += g * bf2f(w.x & 0xffffu); v[j].y += g * bf2f(w.x >> 16); v[j].z += g * bf2f(w.y & 0xffffu); v[j].w += g * bf2f(w.y >> 16);
            }
            ((f32x4*)(H2 + (size_t)m * D))[lane + 64 * j] = v[j];
            ss += (v[j].x * v[j].x + v[j].y * v[j].y) + (v[j].z * v[j].z + v[j].w * v[j].w);
        }
        const float rstd = 1.0f / sqrtf(wave_sum(ss) * (1.f / D) + EPS);
#pragma unroll
        for (int j = 0; j < 4; ++j) {
            const f32x4 g = ((const f32x4*)p.g_ple)[lane + 64 * j];
            const f32x4 y = v[j] * rstd * g;
            u32x2 o; o.x = pk2(y.x, y.y); o.y = pk2(y.z, y.w);
            *((u32x2*)(XN + (size_t)m * D) + lane + 64 * j) = o;
        }
    }
}

__device__ __forceinline__ void ph_gate(const P& p, LAS unsigned char* lds, int bid, int nb) {
    pg8::DenseSched S; S.init(p.ws + WS_XN, p.ws + WS_WG_T, M, D, D, nb, bid);
    pg8::EpiGate E{(const float*)(p.ws + WS_H2), (const bf16*)(p.ws + WS_PP), p.out, D};
    pg8::gemm_phase<pg8::EpiGate, pg8::DenseSched, true>(lds, D, S, E);
}

__device__ void ph_final(const P& p, int bid, int nb) {
    const int tid = opaque_tid(), lane = tid & 63, wave = tid >> 6;
    const int gw = bid * NWAVE + wave, ngw = nb * NWAVE;
    for (int m = gw; m < M; m += ngw) {
        f32x4* xr = (f32x4*)(p.out + (size_t)m * D) + lane;
        f32x4 v[4]; float ss = 0.f;
#pragma unroll
        for (int j = 0; j < 4; ++j) { v[j] = xr[64 * j]; ss += (v[j].x * v[j].x + v[j].y * v[j].y) + (v[j].z * v[j].z + v[j].w * v[j].w); }
        const float rstd = 1.0f / sqrtf(wave_sum(ss) * (1.f / D) + EPS);
#pragma unroll
        for (int j = 0; j < 4; ++j) xr[64 * j] = v[j] * rstd * ((const f32x4*)p.g_final)[lane + 64 * j];
    }
}

__global__ void __launch_bounds__(NT, 2) k_mega(P p) {
    extern __shared__ __attribute__((aligned(16))) unsigned char lds_raw[];
    LAS unsigned char* lds = (LAS unsigned char*)lds_raw;
    cg::grid_group grid = cg::this_grid();
    const int bid = blockIdx.x, nb = gridDim.x;
    if (threadIdx.x < 2) ((volatile LAS unsigned*)(lds + LDS_MISC))[threadIdx.x] = 0u;
    __syncthreads();
    XcdBarrier bar = xcd_barrier_post((unsigned*)(p.ws + WS_CTL) + CW_BAR, (volatile LAS unsigned*)(lds + LDS_MISC));
#if defined(__HIP_DEVICE_COMPILE__)
#define PH(call) do { typedef const __attribute__((address_space(4))) P CP; CP* kp_ = (CP*)__builtin_amdgcn_kernarg_segment_ptr(); asm volatile("" : "+s"(kp_)); const P q = *kp_; call; } while (0)
#else
#define PH(call) do { const P q = p; call; } while (0)
#endif
    PH(ph_prologue(q, lds, bid, nb)); PH(ph_prologue_rows(q, lds, bid, nb)); grid.sync();
    PH(ph_inproj(q, lds, bid, nb)); xcd_barrier(bar);
    PH(ph_attn(q, (char*)lds_raw, bid, nb)); xcd_barrier(bar);
    PH(ph_combine(q, bid, nb)); xcd_barrier(bar);
    PH(ph_outproj(q, lds, bid, nb)); xcd_barrier(bar);
    PH(ph_route(q, lds, bid, nb)); xcd_barrier(bar);
    PH(ph_route2(q, lds, bid, nb)); xcd_barrier(bar);
    PH(ph_moe1(q, lds, bid, nb)); xcd_barrier(bar);
    PH(ph_moe2(q, lds, bid, nb)); xcd_barrier(bar);
    PH(ph_combine2(q, bid, nb)); xcd_barrier(bar);
    PH(ph_gate(q, lds, bid, nb)); xcd_barrier(bar);
    PH(ph_final(q, bid, nb));
#undef PH
}

extern "C" void kernel_launch(void* const* d_in, const int* in_sizes, int n_in, void* d_out, int out_size, void* d_ws, size_t ws_size, hipStream_t stream) {
    if (n_in != 23 || in_sizes[0] != M * D || out_size != M * D || ws_size < WS_END) {
        fprintf(stderr, "kernel_launch: unexpected shapes (n_in %d in0 %d out %d ws %zu)\n", n_in, n_in > 0 ? in_sizes[0] : -1, out_size, ws_size); return; }
    static int grid_blocks = 0;
    if (!grid_blocks) {
        int dev = 0, cus = 0, per_cu = 0;
        hipGetDevice(&dev);
        hipDeviceGetAttribute(&cus, hipDeviceAttributeMultiprocessorCount, dev);
        hipFuncSetAttribute((const void*)k_mega, hipFuncAttributeMaxDynamicSharedMemorySize, LDS_BYTES);
        hipOccupancyMaxActiveBlocksPerMultiprocessor(&per_cu, k_mega, NT, LDS_BYTES);
        if (per_cu < 1) { fprintf(stderr, "kernel_launch: occupancy query says %d blocks per CU\n", per_cu); per_cu = 1; }
        grid_blocks = cus * per_cu;
    }
    P p{};
    p.x = (const float*)d_in[0]; p.p = (const float*)d_in[1]; p.pos = (const int*)d_in[2]; p.g_attn = (const float*)d_in[3]; p.w_in = (const float*)d_in[4];
    p.lq1 = (const float*)d_in[5]; p.lk1 = (const float*)d_in[6]; p.lq2 = (const float*)d_in[7]; p.lk2 = (const float*)d_in[8]; p.g_subln = (const float*)d_in[9];
    p.b_forget = (const float*)d_in[10]; p.w_out = (const float*)d_in[11]; p.g_moe = (const float*)d_in[12]; p.w_router = (const float*)d_in[13]; p.b_router = (const float*)d_in[14];
    p.w_e1 = (const float*)d_in[15]; p.b_e1 = (const float*)d_in[16]; p.w_e2 = (const float*)d_in[17]; p.b_e2 = (const float*)d_in[18];
    p.g_ple = (const float*)d_in[19]; p.w_gate = (const float*)d_in[20]; p.w_proj = (const float*)d_in[21]; p.g_final = (const float*)d_in[22];
    p.out = (float*)d_out; p.ws = (unsigned char*)d_ws;
    if (hipMemsetAsync((char*)d_ws + WS_CTL, 0, CTL_ZERO_BYTES, stream) != hipSuccess) { fprintf(stderr, "kernel_launch: memset of the control words failed\n"); return; }
    void* args[] = {&p};
    hipError_t e = hipLaunchCooperativeKernel((void*)k_mega, dim3(grid_blocks), dim3(NT), args, LDS_BYTES, stream);
    if (e != hipSuccess) fprintf(stderr, "cooperative launch failed: %s (grid %d)\n", hipGetErrorString(e), grid_blocks);
}
```

```cpp
#include <hip/hip_runtime.h>
#include <hip/hip_cooperative_groups.h>
#include <hip/hip_bf16.h>
#include <cstdio>
#include <cstdint>
namespace cg = cooperative_groups;

constexpr int NB = 8, SEQ = 2048, D = 1024, M = NB * SEQ;
constexpr int INW = 3080, NPROJ = 3072;
constexpr int NE = 32, TOPK = 4, DE = 1024, PLE = 256;
constexpr float EPS = 1e-5f;
constexpr float LOG2E = 1.4426950408889634f;
constexpr float QSCALE = 0.125f * LOG2E;
constexpr float LAMBDA_INIT = 0.2f;
constexpr int NT = 512, NWAVE = 8;

typedef unsigned short bf16;
typedef short bf16x8 __attribute__((ext_vector_type(8)));
typedef float f32x4 __attribute__((ext_vector_type(4)));
typedef float f32x2 __attribute__((ext_vector_type(2)));
typedef unsigned u32x4 __attribute__((ext_vector_type(4)));
typedef unsigned u32x2 __attribute__((ext_vector_type(2)));

constexpr size_t MiB = 1u << 20;
constexpr size_t WS_CTL = 0;
constexpr size_t CTL_ZERO_BYTES = 65536; constexpr int CW_BAR = 4096;
constexpr size_t WS_COS = 1 * MiB;
constexpr size_t WS_SIN = WS_COS + 512 * 1024;
constexpr size_t WS_LOGF = 2 * MiB;
constexpr size_t WS_CUM = WS_LOGF + 512 * 1024;
constexpr size_t WS_GATE = 3 * MiB;
constexpr size_t WS_WRT = 3 * MiB + 512 * 1024;
constexpr size_t WS_BCNT = 3 * MiB + 768 * 1024;
constexpr size_t WS_SCL = 3 * MiB + 832 * 1024;
constexpr size_t WS_SS = 6 * MiB;
constexpr size_t WS_LIST = 4 * MiB;
constexpr size_t WS_XN = 8 * MiB;
constexpr size_t WS_PROJ = 40 * MiB;
constexpr size_t WS_OATT = 136 * MiB;
constexpr size_t WS_MIXED = 184 * MiB;
constexpr size_t WS_H1 = 216 * MiB;
constexpr size_t WS_PP = 280 * MiB;
constexpr size_t WS_ACT = 312 * MiB;
constexpr size_t WS_Y = 456 * MiB;
constexpr size_t WS_H2 = 584 * MiB;
constexpr size_t WS_WIN_T = 648 * MiB;
constexpr size_t WS_WO_T = 654 * MiB;
constexpr size_t WS_WG_T = 656 * MiB;
constexpr size_t WS_WP_T = 658 * MiB;
constexpr size_t WS_PB = 660 * MiB;
constexpr size_t WS_W1_T = 668 * MiB;
constexpr size_t WS_W2_T = 796 * MiB;
constexpr size_t WS_END = 860 * MiB;

constexpr int RING_BYTES = 131072;
constexpr int LDS_TAB = RING_BYTES;
constexpr int LDS_ROWMAP = RING_BYTES + 1024;
constexpr int LDS_MISC = RING_BYTES + 12288;
constexpr int LDS_SEL = RING_BYTES + 12544;
constexpr int LDS_BYTES = 147456;

struct P {
    const float* x; const float* p; const int* pos; const float* g_attn; const float* w_in;
    const float* lq1; const float* lk1; const float* lq2; const float* lk2; const float* g_subln; const float* b_forget;
    const float* w_out; const float* g_moe; const float* w_router; const float* b_router;
    const float* w_e1; const float* b_e1; const float* w_e2; const float* b_e2;
    const float* g_ple; const float* w_gate; const float* w_proj; const float* g_final;
    float* out; unsigned char* ws;
};

__device__ __forceinline__ unsigned f2bf(float f) { unsigned u = __builtin_bit_cast(unsigned, f); return (u + 0x7fffu + ((u >> 16) & 1u)) >> 16; }
__device__ __forceinline__ float bf2f(unsigned h) { return __builtin_bit_cast(float, h << 16); }
__device__ __forceinline__ unsigned pk2(float lo, float hi) { return f2bf(lo) | (f2bf(hi) << 16); }
__device__ __forceinline__ float wave_sum(float v) {
#pragma unroll
    for (int o = 1; o < 64; o <<= 1) v += __shfl_xor(v, o);
    return v;
}
__device__ __forceinline__ int opaque_tid() { int t = threadIdx.x; asm volatile("" : "+v"(t)); return t; }
__device__ __forceinline__ float clamp8(float v) { return fminf(fmaxf(v, -448.f), 448.f); }
__device__ __forceinline__ unsigned pk4_fp8(float a, float b, float c, float d) { int w = __builtin_amdgcn_cvt_pk_fp8_f32(clamp8(a), clamp8(b), 0, false); w = __builtin_amdgcn_cvt_pk_fp8_f32(clamp8(c), clamp8(d), w, true); return (unsigned)w; }
__device__ __forceinline__ float sigmoidf_(float z) { return 1.0f / (1.0f + __expf(-z)); }

struct SgLds { bf16 a[128][40]; bf16 b[128][40]; };

template <bool A_F32, class RowPtr, class ColMap, class Epi>
__device__ __forceinline__ void sgemm_tile(SgLds& L, RowPtr rowptr, int K, const float* __restrict__ W, int ldw, ColMap colmap, Epi epi) {
    const int tid = opaque_tid(), lane = tid & 63, wid = tid >> 6, wr = wid >> 1, wc = wid & 1, fr = lane & 15, fq = lane >> 4;
    const int ar = tid >> 2, akc = (tid & 3) * 8;
    const void* aptr = rowptr(ar);
    const int bk = tid >> 4, bnc = (tid & 15) * 8;
    int wcol[8];
#pragma unroll
    for (int i = 0; i < 8; ++i) wcol[i] = colmap(bnc + i);
    f32x4 acc[2][4];
#pragma unroll
    for (int m = 0; m < 2; ++m)
#pragma unroll
        for (int n = 0; n < 4; ++n) acc[m][n] = (f32x4){0.f, 0.f, 0.f, 0.f};
    for (int k0 = 0; k0 < K; k0 += 32) {
        u32x4 av = (u32x4){0u, 0u, 0u, 0u};
        if (aptr) {
            if (A_F32) { const float* ap = (const float*)aptr + k0 + akc; const f32x4 v0 = *(const f32x4*)ap, v1 = *(const f32x4*)(ap + 4);
                av.x = pk2(v0.x, v0.y); av.y = pk2(v0.z, v0.w); av.z = pk2(v1.x, v1.y); av.w = pk2(v1.z, v1.w); }
            else av = *(const u32x4*)((const bf16*)aptr + k0 + akc);
        }
        float wv[8];
#pragma unroll
        for (int i = 0; i < 8; ++i) wv[i] = W[(size_t)(k0 + bk) * ldw + wcol[i]];
        __syncthreads();
        *(u32x4*)&L.a[ar][akc] = av;
#pragma unroll
        for (int i = 0; i < 8; ++i) L.b[bnc + i][bk] = (bf16)f2bf(wv[i]);
        __syncthreads();
        bf16x8 af[2], bfr[4];
#pragma unroll
        for (int m = 0; m < 2; ++m) af[m] = *(const bf16x8*)&L.a[wr * 32 + m * 16 + fr][fq * 8];
#pragma unroll
        for (int n = 0; n < 4; ++n) bfr[n] = *(const bf16x8*)&L.b[wc * 64 + n * 16 + fr][fq * 8];
#pragma unroll
        for (int m = 0; m < 2; ++m)
#pragma unroll
            for (int n = 0; n < 4; ++n) acc[m][n] = __builtin_amdgcn_mfma_f32_16x16x32_bf16(af[m], bfr[n], acc[m][n], 0, 0, 0);
    }
    epi(acc, wr, wc, fr, fq);
}

namespace pg8 {
#define PG8_LAS __attribute__((address_space(3)))
constexpr int BM = 256, BK = 64, HALF = 128, HTB = HALF * BK * 2  , STAGE_BYTES = 8 * HTB, NXCD = 8, WGM = 8;

__host__ __device__ __forceinline__ int lds_byte(int r, int c) { const int st = (r >> 4) * 2 + (c >> 5), rr = r & 15, cc = c & 31, ob = rr * 64 + cc * 2; return st * 1024 + (ob ^ (((ob >> 9) & 1) << 5)); }
__host__ __device__ __forceinline__ void stage_rc(int b, int& R, int& C) { const int st = b / 1024, sb = b % 1024, swz = sb ^ (((sb >> 9) & 1) << 5); R = (st >> 1) * 16 + swz / 64; C = (st & 1) * 32 + (swz % 64) / 2; }
__host__ __device__ __forceinline__ int perm32(int rho) { const int n = rho >> 4, i = rho & 15; return 8 * (i >> 2) + 4 * n + (i & 3); }

typedef int v4i_t __attribute__((ext_vector_type(4))); typedef int v8i_t __attribute__((ext_vector_type(8)));
__device__ __forceinline__ void mfma_f8(f32x4& c, const v8i_t a, const v8i_t b, const int sc) { asm("v_mfma_scale_f32_16x16x128_f8f6f4 %0, %1, %2, %0, %3, %3 op_sel_hi:[0,0,0]" : "+v"(c) : "v"(a), "v"(b), "v"(sc)); }
struct Unit { int pm, pn, e, li; };

struct DenseSched {
    int nM, nN, nwg, G, c, K; const char* A; const char* Bt;
    __device__ void init(const void* A_, const void* Bt_, int M_, int N_, int K_, int G_, int c_) { A = (const char*)A_; Bt = (const char*)Bt_; nM = M_ / BM; nN = N_ / BM; nwg = nM * nN; G = G_; c = c_; K = K_; }
    __device__ bool next(int i, Unit& u) const {
        const long L = (long)i * G + c; if (L >= nwg) return false;
        int wgid = (int)L; { const int q = nwg / NXCD, r = nwg % NXCD, xcd = wgid % NXCD, off = wgid / NXCD; wgid = (xcd < r ? xcd * (q + 1) : r * (q + 1) + (xcd - r) * q) + off; }
        const int nig = WGM * nN, gid = wgid / nig, fm = gid * WGM, gsz = (nM - fm) < WGM ? (nM - fm) : WGM;
        u.pm = fm + ((wgid % nig) % gsz); u.pn = (wgid % nig) / gsz; u.e = 0; u.li = i; return true;
    }
    static constexpr bool GATHER = false;
    __device__ __forceinline__ const char* a_base() const { return A; }
    __device__ __forceinline__ unsigned a_row(const Unit& u, int r) const { return (unsigned)(u.pm * BM + r); }
    __device__ __forceinline__ const char* b_ptr(const Unit& u) const { return Bt + (size_t)u.pn * BM * K * 2; }
};

__device__ __forceinline__ unsigned cvt_pk_bf16(float lo, float hi) { unsigned r; asm volatile("v_cvt_pk_bf16_f32 %0, %1, %2" : "=v"(r) : "v"(lo), "v"(hi)); return r; }
__device__ __forceinline__ float sigm(float z) { return __builtin_amdgcn_rcpf(1.0f + __builtin_amdgcn_exp2f(-LOG2E * z)); }

struct EpiBf16 {
    static constexpr bool PERM = true;
    bf16* O; int ldc;
    __device__ __forceinline__ void operator()(const f32x4 (&acc)[2][2][4][2], const Unit& u, int wr, int wc, int fr, int fq) const {
        const int row0 = u.pm * BM + wr * 64 + fr, col0 = u.pn * BM + wc * 32 + 8 * fq;
#pragma unroll
        for (int ai = 0; ai < 2; ++ai)
#pragma unroll
            for (int m = 0; m < 4; ++m) { bf16* rowp = O + (size_t)(row0 + ai * HALF + m * 16) * ldc + col0;
#pragma unroll
                for (int bj = 0; bj < 2; ++bj) { const f32x4 v0 = acc[ai][bj][m][0], v1 = acc[ai][bj][m][1];
                    u32x4 w; w.x = cvt_pk_bf16(v0[0], v0[1]); w.y = cvt_pk_bf16(v0[2], v0[3]); w.z = cvt_pk_bf16(v1[0], v1[1]); w.w = cvt_pk_bf16(v1[2], v1[3]);
                    *(u32x4*)(rowp + bj * HALF) = w; } }
    }
};
struct EpiInproj {
    static constexpr bool PERM = true;
    bf16* O; const float* COS; const float* SIN;
    __device__ __forceinline__ void operator()(const f32x4 (&acc)[2][2][4][2], const Unit& u, int wr, int wc, int fr, int fq) const {
        const int row0 = u.pm * BM + wr * 64 + fr, colt = u.pn * BM, col0 = colt + wc * 32 + 8 * fq;
        const bool rope = (colt < 1024) && ((wc & 1) == 0);
        const float sc = (colt < 512 || (colt >= 1536 && colt < 2048)) ? QSCALE : 1.0f;
#pragma unroll
        for (int ai = 0; ai < 2; ++ai)
#pragma unroll
            for (int m = 0; m < 4; ++m) {
                const int row = row0 + ai * HALF + m * 16; bf16* rowp = O + (size_t)row * NPROJ + col0;
#pragma unroll
                for (int bj = 0; bj < 2; ++bj) { f32x4 v[2] = {acc[ai][bj][m][0], acc[ai][bj][m][1]};
                    if (rope) {
#pragma unroll
                        for (int n = 0; n < 2; ++n) { const f32x4 c = *(const f32x4*)(COS + (size_t)row * 8 + 4 * n), s = *(const f32x4*)(SIN + (size_t)row * 8 + 4 * n); f32x4 pr;
#pragma unroll
                            for (int i = 0; i < 4; ++i) pr[i] = __shfl_xor(v[n][i], 16);
                            const f32x4 lo = v[n] * c - pr * s, hi = v[n] * c + pr * s;
                            v[n] = (fq == 0) ? lo : (fq == 1) ? hi : v[n]; } }
                    v[0] = v[0] * sc; v[1] = v[1] * sc;
                    u32x4 w; w.x = cvt_pk_bf16(v[0][0], v[0][1]); w.y = cvt_pk_bf16(v[0][2], v[0][3]); w.z = cvt_pk_bf16(v[1][0], v[1][1]); w.w = cvt_pk_bf16(v[1][2], v[1][3]);
                    *(u32x4*)(rowp + bj * HALF) = w; } }
    }
};
struct EpiResF32 {
    static constexpr bool PERM = false;
    const float* base; float* C; int ldc; float* SS;
    __device__ __forceinline__ void operator()(const f32x4 (&acc)[2][2][4][2], const Unit& u, int wr, int wc, int fr, int fq) const {
        const int row0 = u.pm * BM + wr * 64 + fr, col0 = u.pn * BM + wc * 32 + 4 * fq;
#pragma unroll
        for (int ai = 0; ai < 2; ++ai)
#pragma unroll
            for (int m = 0; m < 4; ++m) { const int row = row0 + ai * HALF + m * 16; const size_t off = (size_t)row * ldc + col0; float ss = 0.f;
#pragma unroll
                for (int bj = 0; bj < 2; ++bj)
#pragma unroll
                    for (int n = 0; n < 2; ++n) { const f32x4 v = *(const f32x4*)(base + off + bj * HALF + n * 16) + acc[ai][bj][m][n]; *(f32x4*)(C + off + bj * HALF + n * 16) = v; ss += (v[0] * v[0] + v[1] * v[1]) + (v[2] * v[2] + v[3] * v[3]); }
                ss += __shfl_xor(ss, 16); ss += __shfl_xor(ss, 32);
                if (fq == 0) SS[(size_t)row * 16 + u.pn * 4 + wc] = ss; }
    }
};
struct EpiGate {
    static constexpr bool PERM = false;
    const float* H2; const bf16* PP; float* C; int ldc;
    __device__ __forceinline__ void operator()(const f32x4 (&acc)[2][2][4][2], const Unit& u, int wr, int wc, int fr, int fq) const {
        const int row0 = u.pm * BM + wr * 64 + fr, col0 = u.pn * BM + wc * 32 + 4 * fq;
#pragma unroll
        for (int ai = 0; ai < 2; ++ai)
#pragma unroll
            for (int m = 0; m < 4; ++m) { const size_t off = (size_t)(row0 + ai * HALF + m * 16) * ldc + col0;
#pragma unroll
                for (int bj = 0; bj < 2; ++bj)
#pragma unroll
                    for (int n = 0; n < 2; ++n) { const size_t o = off + bj * HALF + n * 16; const u32x2 pw = *(const u32x2*)(PP + o); const f32x4 a = acc[ai][bj][m][n];
                        f32x4 r = *(const f32x4*)(H2 + o);
                        r[0] += sigm(a[0]) * __builtin_bit_cast(float, pw.x << 16); r[1] += sigm(a[1]) * __builtin_bit_cast(float, pw.x & 0xffff0000u);
                        r[2] += sigm(a[2]) * __builtin_bit_cast(float, pw.y << 16); r[3] += sigm(a[3]) * __builtin_bit_cast(float, pw.y & 0xffff0000u);
                        *(f32x4*)(C + o) = r; } }
    }
};

struct MoeTab { int tstart[33]; int rbase[32]; int cnt[32]; int mt[32]; };
static_assert(sizeof(MoeTab) <= 1024, "MoeTab must fit below the row maps");
template <int MODE  > struct MoeSched {
    static constexpr bool GATHER = (MODE == 1);
    const PG8_LAS MoeTab* T; const PG8_LAS int* rowmap; int nN, G, c, K; const char* A; const char* Bt; size_t bstride;
    __device__ bool next(int i, Unit& u) const {
        const int nwg = __builtin_amdgcn_readfirstlane(T->tstart[32]); const long L = (long)i * G + c; if (L >= nwg) return false;
        int wgid = (int)L; { const int q = nwg / NXCD, r = nwg % NXCD, xcd = wgid % NXCD, off = wgid / NXCD; wgid = (xcd < r ? xcd * (q + 1) : r * (q + 1) + (xcd - r) * q) + off; }
        int e = 0;
        for (int j = 1; j < 32; ++j) e = (wgid >= T->tstart[j]) ? j : e;
        e = __builtin_amdgcn_readfirstlane(e);
        const int r = wgid - __builtin_amdgcn_readfirstlane(T->tstart[e]), mt = __builtin_amdgcn_readfirstlane(T->mt[e]);
        u.e = e; u.pm = r % mt; u.pn = r / mt; u.li = i; return true;
    }
    __device__ __forceinline__ const char* a_base() const { return A; }
    __device__ __forceinline__ unsigned a_row(const Unit& u, int r) const { return MODE == 1 ? (unsigned)rowmap[u.li * 256 + r] : (unsigned)(__builtin_amdgcn_readfirstlane(T->rbase[u.e]) + u.pm * BM + r); }
    __device__ __forceinline__ const char* b_ptr(const Unit& u) const { return Bt + (size_t)u.e * bstride + (size_t)u.pn * BM * K * 2; }
};
__device__ __forceinline__ float swiglu(float g, float l) { const float glu = fminf(g, 7.0f), lin = fminf(fmaxf(l, -7.0f), 7.0f); return glu * sigm(1.702f * glu) * (lin + 1.0f); }
struct EpiMoe1 {
    static constexpr bool PERM = true;
    unsigned char* ACT; const float* B1; const PG8_LAS MoeTab* T; const float* INV;
    __device__ __forceinline__ void operator()(const f32x4 (&acc)[2][2][4][2], const Unit& u, int wr, int wc, int fr, int fq) const {
        const int row0 = T->rbase[u.e] + u.pm * BM + wr * 64 + fr, acol0 = u.pn * 128 + wc * 16 + 4 * fq;
        const float* bp = B1 + (size_t)u.e * 2 * DE + u.pn * BM + wc * 32 + 8 * fq; const float inv = INV[u.e];
        f32x4 bv[2][2];
#pragma unroll
        for (int bj = 0; bj < 2; ++bj)
#pragma unroll
            for (int n = 0; n < 2; ++n) bv[bj][n] = *(const f32x4*)(bp + bj * HALF + 4 * n);
#pragma unroll
        for (int ai = 0; ai < 2; ++ai)
#pragma unroll
            for (int m = 0; m < 4; ++m) { unsigned char* rowp = ACT + (size_t)(row0 + ai * HALF + m * 16) * DE + acol0;
#pragma unroll
                for (int bj = 0; bj < 2; ++bj) { const f32x4 v0 = acc[ai][bj][m][0] * inv + bv[bj][0], v1 = acc[ai][bj][m][1] * inv + bv[bj][1];
                    *(unsigned*)(rowp + bj * 64) = pk4_fp8(swiglu(v0[0], v0[1]), swiglu(v0[2], v0[3]), swiglu(v1[0], v1[1]), swiglu(v1[2], v1[3])); } }
    }
};
struct EpiMoe2 {
    static constexpr bool PERM = true;
    bf16* Y; const float* B2; const PG8_LAS int* rowmap; const float* INV;
    __device__ __forceinline__ void operator()(const f32x4 (&acc)[2][2][4][2], const Unit& u, int wr, int wc, int fr, int fq) const {
        const int col0 = u.pn * BM + wc * 32 + 8 * fq;
        const float* bp = B2 + (size_t)u.e * D + col0; const float inv = INV[u.e];
        f32x4 bv[2][2];
#pragma unroll
        for (int bj = 0; bj < 2; ++bj)
#pragma unroll
            for (int n = 0; n < 2; ++n) bv[bj][n] = *(const f32x4*)(bp + bj * HALF + 4 * n);
#pragma unroll
        for (int ai = 0; ai < 2; ++ai)
#pragma unroll
            for (int m = 0; m < 4; ++m) { const int slot = rowmap[u.li * 256 + ai * HALF + wr * 64 + m * 16 + fr];
                if (slot >= 0) { bf16* rowp = Y + (size_t)slot * D + col0;
#pragma unroll
                    for (int bj = 0; bj < 2; ++bj) { const f32x4 v0 = acc[ai][bj][m][0] * inv + bv[bj][0], v1 = acc[ai][bj][m][1] * inv + bv[bj][1];
                        u32x4 w; w.x = cvt_pk_bf16(v0[0], v0[1]); w.y = cvt_pk_bf16(v0[2], v0[3]); w.z = cvt_pk_bf16(v1[0], v1[1]); w.w = cvt_pk_bf16(v1[2], v1[3]);
                        *(u32x4*)(rowp + bj * HALF) = w; } } }
    }
};

template <class Epi, class Sched, bool ALIGN_EPI, bool F8 = false>
__device__ __forceinline__ void gemm_phase(PG8_LAS unsigned char* lds, const int K, const Sched& S, const Epi& E) {
    constexpr bool GA = Sched::GATHER;
    int tid_ = opaque_tid();
    const int tid = tid_, wid = __builtin_amdgcn_readfirstlane(tid >> 6), lane = tid & 63, wr = wid >> 2, wc = wid & 3, fr = lane & 15, fq = lane >> 4;
    const int nt = K / BK;
    unsigned voffA[2], voffB[2];
#pragma unroll
    for (int i = 0; i < 2; ++i) { int R, C; stage_rc(tid * 16 + i * 8192, R, C); const int Rb = Epi::PERM ? ((R & ~31) + perm32(R & 31)) : R;
        voffA[i] = (unsigned)(R * K + C) * 2u; voffB[i] = (unsigned)(Rb * K + C) * 2u; }
    const size_t kstep = (size_t)(BK * 2);
    const size_t hstep = (size_t)HALF * K * 2;
    const unsigned ldsw = (unsigned)wid * 1024u;
    const int aoff = lds_byte(wr * 64 + fr, fq * 8), boff = lds_byte(wc * 32 + fr, fq * 8);
    const char* const Ab = S.a_base();
#define PG8_SA(b, h) (((b) * 2 + (h)) * HTB)
#define PG8_SB(b, h) ((4 + (b) * 2 + (h)) * HTB)
#define PG8_STAGE(bufoff, gbase, voff) do { _Pragma("unroll") for (int _i = 0; _i < 2; ++_i) \
        __builtin_amdgcn_global_load_lds((const unsigned*)((const char*)(gbase) + (voff)[_i]), (PG8_LAS unsigned*)(lds + (bufoff) + ldsw + _i * 8192), 16, 0, 0); } while (0)
#define PG8_STAGE_A(bufoff, up, vp, h, ko) do { if constexpr (GA) PG8_STAGE(bufoff, Ab + (ko), (vp)[h]); else PG8_STAGE(bufoff, (up) + (h) * hstep + (ko), voffA); } while (0)
#define PG8_LDA(dst, b, h) do { _Pragma("unroll") for (int m = 0; m < 4; ++m) _Pragma("unroll") for (int k = 0; k < 2; ++k) dst[m][k] = *(const PG8_LAS bf16x8*)(lds + PG8_SA(b, h) + aoff + m * 2048 + k * 1024); } while (0)
#define PG8_LDB(dst, b, h) do { _Pragma("unroll") for (int n = 0; n < 2; ++n) _Pragma("unroll") for (int k = 0; k < 2; ++k) dst[n][k] = *(const PG8_LAS bf16x8*)(lds + PG8_SB(b, h) + boff + n * 2048 + k * 1024); } while (0)
#define PG8_CAT(x) __builtin_shufflevector(__builtin_bit_cast(v4i_t, (x)[0]), __builtin_bit_cast(v4i_t, (x)[1]), 0, 1, 2, 3, 4, 5, 6, 7)
#define PG8_MMA(ai, bj, At, Bt) do { __builtin_amdgcn_s_setprio(1); _Pragma("unroll") for (int m = 0; m < 4; ++m) _Pragma("unroll") for (int n = 0; n < 2; ++n) { \
        if constexpr (F8) mfma_f8(acc[ai][bj][m][n], PG8_CAT(Bt[n]), PG8_CAT(At[m]), one8); \
        else { _Pragma("unroll") for (int k = 0; k < 2; ++k) acc[ai][bj][m][n] = __builtin_amdgcn_mfma_f32_16x16x32_bf16(Bt[n][k], At[m][k], acc[ai][bj][m][n], 0, 0, 0); } } __builtin_amdgcn_s_setprio(0); } while (0)
#define PG8_WAIT_V(n) asm volatile("s_waitcnt vmcnt(" #n ")" ::: "memory")
#define PG8_WAIT_L(n) asm volatile("s_waitcnt lgkmcnt(" #n ")" ::: "memory")
#define PG8_BAR __builtin_amdgcn_s_barrier()
#define PG8_SCHED __builtin_amdgcn_sched_barrier(0)
#define PG8_AOFF(dst, u) do { if constexpr (GA) { _Pragma("unroll") for (int _h = 0; _h < 2; ++_h) _Pragma("unroll") for (int _i = 0; _i < 2; ++_i) { int R_, C_; stage_rc(tid * 16 + _i * 8192, R_, C_); \
        dst[_h][_i] = S.a_row(u, _h * HALF + R_) * (unsigned)(K * 2) + (unsigned)C_ * 2u; } } } while (0)
    Unit cur, nxt; int ui = 0;
    if (!S.next(0, cur)) return;
    f32x4 acc[2][2][4][2];
#pragma unroll
    for (int a = 0; a < 2; ++a)
#pragma unroll
        for (int b = 0; b < 2; ++b)
#pragma unroll
            for (int m = 0; m < 4; ++m)
#pragma unroll
                for (int n = 0; n < 2; ++n) acc[a][b][m][n] = (f32x4){0.f, 0.f, 0.f, 0.f};
    bf16x8 At[4][2], B0[2][2], B1[2][2];
    int one8 = 0x7F7F7F7F; asm volatile("" : "+v"(one8));
    unsigned vAc[2][2];
    PG8_AOFF(vAc, cur);
    const char* cA = GA ? Ab : Ab + (size_t)S.a_row(cur, 0) * K * 2;
    const char* cB = S.b_ptr(cur);
    PG8_STAGE(PG8_SB(0, 0), cB, voffB); PG8_STAGE(PG8_SB(0, 1), cB + hstep, voffB); PG8_STAGE_A(PG8_SA(0, 0), cA, vAc, 0, 0); PG8_STAGE_A(PG8_SA(0, 1), cA, vAc, 1, 0);
    if (wr == 1) PG8_BAR;
    PG8_WAIT_V(2); PG8_BAR;
    PG8_STAGE(PG8_SB(1, 0), cB + kstep, voffB); PG8_STAGE_A(PG8_SA(1, 0), cA, vAc, 0, kstep); PG8_STAGE(PG8_SB(1, 1), cB + hstep + kstep, voffB);
    PG8_WAIT_V(6); PG8_BAR;
    for (;;) {
        const bool has_next = S.next(ui + 1, nxt);
        const char* nB = cB; const char* nA = cA;
        if (has_next) { nB = S.b_ptr(nxt); if constexpr (!GA) nA = Ab + (size_t)S.a_row(nxt, 0) * K * 2; }
#pragma nounroll
        for (int t = 0; t < nt; t += 2) {
            const bool last = (t == nt - 2);
            const size_t k1 = (size_t)(t + 1) * kstep, k2 = last ? 0 : (size_t)(t + 2) * kstep, k3 = k2 + kstep;
            const char* a2 = last ? nA : cA; const char* b2 = last ? nB : cB + (size_t)(t + 2) * kstep; const char* b3 = b2 + kstep;
            unsigned v2[2][2];
            if constexpr (GA) {
                if (last && has_next) PG8_AOFF(v2, nxt);
                else {
#pragma unroll
                    for (int h = 0; h < 2; ++h)
#pragma unroll
                        for (int i = 0; i < 2; ++i) v2[h][i] = vAc[h][i];
                }
            }
            PG8_LDB(B0, 0, 0); PG8_LDB(B1, 0, 1); PG8_SCHED; PG8_LDA(At, 0, 0); PG8_STAGE_A(PG8_SA(1, 1), cA, vAc, 1, k1);
            PG8_WAIT_V(8); PG8_WAIT_L(0); PG8_BAR; PG8_MMA(0, 0, At, B0); PG8_MMA(0, 1, At, B1); PG8_BAR; PG8_SCHED;
            PG8_LDA(At, 0, 1); PG8_STAGE(PG8_SB(0, 0), b2, voffB); PG8_STAGE(PG8_SB(0, 1), b2 + hstep, voffB); PG8_STAGE_A(PG8_SA(0, 0), a2, v2, 0, k2);
            PG8_WAIT_V(8); PG8_WAIT_L(0); PG8_BAR; PG8_MMA(1, 0, At, B0); PG8_MMA(1, 1, At, B1); PG8_BAR; PG8_SCHED;
            PG8_LDB(B0, 1, 0); PG8_LDB(B1, 1, 1); PG8_SCHED; PG8_LDA(At, 1, 0); PG8_STAGE_A(PG8_SA(0, 1), a2, v2, 1, k2);
            PG8_WAIT_V(8); PG8_WAIT_L(0); PG8_BAR; PG8_MMA(0, 0, At, B0); PG8_MMA(0, 1, At, B1); PG8_BAR; PG8_SCHED;
            PG8_LDA(At, 1, 1); PG8_STAGE(PG8_SB(1, 0), b3, voffB); PG8_STAGE(PG8_SB(1, 1), b3 + hstep, voffB); PG8_STAGE_A(PG8_SA(1, 0), a2, v2, 0, k3);
            PG8_WAIT_V(8); PG8_WAIT_L(0); PG8_BAR; PG8_MMA(1, 0, At, B0); PG8_MMA(1, 1, At, B1); PG8_BAR; PG8_SCHED;
        }
        if constexpr (ALIGN_EPI) { if (wr == 0) PG8_BAR; }
        if constexpr (F8) asm volatile("s_nop 15\n\ts_nop 7" ::: "memory");
        { int fr_ = fr, fq_ = fq; asm volatile("" : "+v"(fr_), "+v"(fq_));
          E(acc, cur, wr, wc, fr_, fq_); }
        if (!has_next) break;
#pragma unroll
        for (int a = 0; a < 2; ++a)
#pragma unroll
            for (int b = 0; b < 2; ++b)
#pragma unroll
                for (int m = 0; m < 4; ++m)
#pragma unroll
                    for (int n = 0; n < 2; ++n) acc[a][b][m][n] = (f32x4){0.f, 0.f, 0.f, 0.f};
        cur = nxt; cA = nA; cB = nB; ++ui;
        PG8_AOFF(vAc, cur);
        if constexpr (ALIGN_EPI) { if (wr == 1) PG8_BAR; }
    }
    PG8_WAIT_V(0);
    if constexpr (!ALIGN_EPI) { if (wr == 0) PG8_BAR; }
    PG8_BAR;
#undef PG8_SA
#undef PG8_SB
#undef PG8_STAGE
#undef PG8_STAGE_A
#undef PG8_LDA
#undef PG8_LDB
#undef PG8_MMA
#undef PG8_CAT
#undef PG8_WAIT_V
#undef PG8_WAIT_L
#undef PG8_BAR
#undef PG8_SCHED
#undef PG8_AOFF
}
}

namespace attn_body {
using bf16=__hip_bfloat16;
using bf16x8=__attribute__((ext_vector_type(8)))short;
using s16x4=__attribute__((ext_vector_type(4)))short;
using f32x16=__attribute__((ext_vector_type(16)))float;
using u32x4=__attribute__((ext_vector_type(4)))unsigned;
constexpr int SEQ=2048,D=64,PQ=3072,PO=1024;
constexpr int NW=8,QBLK=32,QB=QBLK*NW,KVBLK=64,NQB=SEQ/QB;
constexpr int ATTN_UNIT_ROWS=QB;
__device__ __forceinline__ int crow(int r,int hi){return (r&3)+8*(r>>2)+4*hi;}
#define SBAR() __builtin_amdgcn_sched_barrier(0)
__device__ __forceinline__ void cmask(f32x16&p0,f32x16&p1,int jb,int qrel,int hi){
  const float NEG=-INFINITY; int kb=64*jb+4*hi;
  #pragma unroll
  for(int r=0;r<16;++r){int kv=kb+(r&3)+8*(r>>2); if(kv>qrel)p0[r]=NEG; if(kv+32>qrel)p1[r]=NEG;}
}

constexpr int NSLOT=3, SLOTB=8192;
constexpr int LDS_K=0, LDS_V=NSLOT*SLOTB, LDS_WS=2*NSLOT*SLOTB, LDS_OST=LDS_WS+NW*64*4, LDS_BIAS=LDS_OST+NW*4096, LDS_BYTES=LDS_BIAS+SEQ*4;
constexpr float C2=0.125f*1.4426950408889634f;
__device__ __forceinline__ void glds16(const void*gsrc,unsigned lds_dst){unsigned keep;
  asm volatile("s_mov_b32 %0, m0\n\ts_mov_b32 m0, %2\n\ts_nop 0\n\tglobal_load_lds_dwordx4 %1, off\n\ts_mov_b32 m0, %0":"=&s"(keep):"v"(gsrc),"s"(lds_dst):"memory");}
__device__ __forceinline__ float max3f(float a,float b,float c){float r;asm("v_max3_f32 %0, %1, %2, %3":"=v"(r):"v"(a),"v"(b),"v"(c));return r;}
__device__ __forceinline__ float max2f(float a,float b){float r;asm("v_max_f32_e32 %0, %1, %2":"=v"(r):"v"(a),"v"(b));return r;}
__device__ __forceinline__ float fadd_s(float a,float b){float r;asm("v_add_f32_e32 %0, %1, %2":"=v"(r):"v"(a),"v"(b));return r;}
__device__ __forceinline__ float fsub_s(float a,float b){float r;asm("v_sub_f32_e32 %0, %1, %2":"=v"(r):"v"(a),"v"(b));return r;}
typedef float f32x4_t __attribute__((ext_vector_type(4))); typedef float f32x2_t __attribute__((ext_vector_type(2))); typedef __bf16 bf16x2_t __attribute__((ext_vector_type(2)));
__device__ __forceinline__ unsigned cvtpk_s(float lo,float hi){f32x2_t v={lo,hi};bf16x2_t b=__builtin_convertvector(v,bf16x2_t);return __builtin_bit_cast(unsigned,b);}
#define WAIT_BAR(N) asm volatile("s_waitcnt vmcnt(" #N ") lgkmcnt(0)\n\ts_barrier":::"memory")

__device__ __forceinline__ void qkt(f32x16&p0,f32x16&p1,const char*Kslot,const bf16x8*qr,const f32x16&negm,int r32,int hi){
  const char*kb=Kslot+hi*1024+r32*16;
  #pragma unroll
  for(int d0=0;d0<4;++d0){
    const bf16x8 b0=*reinterpret_cast<const bf16x8*>(kb+d0*2048);
    const bf16x8 b1=*reinterpret_cast<const bf16x8*>(kb+d0*2048+512);
    if(d0==0){p0=__builtin_amdgcn_mfma_f32_32x32x16_bf16(b0,qr[0],negm,0,0,0);p1=__builtin_amdgcn_mfma_f32_32x32x16_bf16(b1,qr[0],negm,0,0,0);}
    else{p0=__builtin_amdgcn_mfma_f32_32x32x16_bf16(b0,qr[d0],p0,0,0,0);p1=__builtin_amdgcn_mfma_f32_32x32x16_bf16(b1,qr[d0],p1,0,0,0);}}
}
typedef __attribute__((address_space(3))) const char* lds_cptr;
typedef short v4i16_t __attribute__((ext_vector_type(4)));
__device__ __forceinline__ void kload8(bf16x8*kf,lds_cptr kp){
  kf[0]=*(const __attribute__((address_space(3))) bf16x8*)(kp);      kf[1]=*(const __attribute__((address_space(3))) bf16x8*)(kp+512);
  kf[2]=*(const __attribute__((address_space(3))) bf16x8*)(kp+2048); kf[3]=*(const __attribute__((address_space(3))) bf16x8*)(kp+2560);
  kf[4]=*(const __attribute__((address_space(3))) bf16x8*)(kp+4096); kf[5]=*(const __attribute__((address_space(3))) bf16x8*)(kp+4608);
  kf[6]=*(const __attribute__((address_space(3))) bf16x8*)(kp+6144); kf[7]=*(const __attribute__((address_space(3))) bf16x8*)(kp+6656);
}
__device__ __forceinline__ void kload2(bf16x8*kf,lds_cptr kp,int j){ kf[2*j]=*(const __attribute__((address_space(3))) bf16x8*)(kp+j*2048); kf[2*j+1]=*(const __attribute__((address_space(3))) bf16x8*)(kp+j*2048+512); }
__device__ __forceinline__ s16x4 vtr(lds_cptr p){ return __builtin_bit_cast(s16x4,__builtin_amdgcn_ds_read_tr16_b64_v4i16((__attribute__((address_space(3))) v4i16_t*)p)); }
__device__ __forceinline__ float rowmax(const f32x16&p0,const f32x16&p1){
  float a=max3f(p0[0],p0[1],p1[0]),b=max3f(p0[2],p0[3],p1[1]);a=max3f(a,p1[2],p1[3]);
  #pragma unroll
  for(int r=4;r<16;r+=4){a=max3f(a,p0[r],p0[r+1]);b=max3f(b,p0[r+2],p0[r+3]);a=max3f(a,p1[r],p1[r+1]);b=max3f(b,p1[r+2],p1[r+3]);}
  const float m=max2f(a,b);
  auto rr=__builtin_amdgcn_permlane32_swap(__float_as_uint(m),__float_as_uint(m),false,false);
  return max2f(__uint_as_float(rr[0]),__uint_as_float(rr[1]));
}
__device__ __forceinline__ void pv(f32x16*o,int vb,bf16x8 pa0,bf16x8 pa1,bf16x8 pa2,bf16x8 pa3){
  #pragma unroll
  for(int d0=0;d0<2;++d0){s16x4 lo[4],hi[4];
    #pragma unroll
    for(int ks=0;ks<4;++ks){
      asm volatile("ds_read_b64_tr_b16 %0,%1 offset:%c2":"=&v"(lo[ks]):"v"(vb),"i"(d0*4096+ks*1024):"memory");
      asm volatile("ds_read_b64_tr_b16 %0,%1 offset:%c2":"=&v"(hi[ks]):"v"(vb),"i"(d0*4096+ks*1024+512):"memory");}
    asm volatile("s_waitcnt lgkmcnt(0)":::"memory");SBAR();
    #define PK(k) (bf16x8){lo[k][0],lo[k][1],lo[k][2],lo[k][3],hi[k][0],hi[k][1],hi[k][2],hi[k][3]}
    o[d0]=__builtin_amdgcn_mfma_f32_32x32x16_bf16(pa0,PK(0),o[d0],0,0,0);
    o[d0]=__builtin_amdgcn_mfma_f32_32x32x16_bf16(pa1,PK(1),o[d0],0,0,0);
    o[d0]=__builtin_amdgcn_mfma_f32_32x32x16_bf16(pa2,PK(2),o[d0],0,0,0);
    o[d0]=__builtin_amdgcn_mfma_f32_32x32x16_bf16(pa3,PK(3),o[d0],0,0,0);
    #undef PK
  }
}

#ifndef ATTN_STORE16
#define ATTN_STORE16(p,v) (*(u32x4*)(p)=(v))
#endif
template<int THRL,bool FOX> __device__ __forceinline__ void attn_unit(int b,int qb,int qcol,int kcol,int vcol,int ocol,const bf16*Q,const bf16*__restrict__ K,const bf16*__restrict__ V,bf16*O,const float*__restrict__ CB,char*shm){
  int tid_=threadIdx.x; asm volatile("":"+v"(tid_));
  const int tid=tid_,lane=tid&63,r32=lane&31,hi=lane>>5; const int wid=__builtin_amdgcn_readfirstlane(tid>>6);
  const long rowbase=(long)b*SEQ; const int q0=qb*QB;
  const bf16*Qw=Q+(rowbase+q0+wid*QBLK)*PQ+qcol;
  const bf16*Kh=K+rowbase*PQ+kcol,*Vh=V+rowbase*PQ+vcol;
  const unsigned lds0=(unsigned)(uintptr_t)shm;
  float*wsf=(float*)(shm+LDS_WS)+wid*64;
  const bf16*ksrc=Kh+(long)lane*PQ+wid*8;
  const bf16*vsrc=Vh+(long)(16*(wid&3)+(lane>>2))*PQ+(wid>>2)*32+(lane&3)*8;
  const unsigned kdst=lds0+LDS_K+wid*1024, vdst=lds0+LDS_V+wid*1024;
  #define DMA_K(t,slot) glds16(ksrc+(long)(t)*KVBLK*PQ,(unsigned)__builtin_amdgcn_readfirstlane(kdst+(slot)))
  #define DMA_V(t,slot) glds16(vsrc+(long)(t)*KVBLK*PQ,(unsigned)__builtin_amdgcn_readfirstlane(vdst+(slot)))
  const int vb0=(int)(lds0+LDS_V)+((lane>>4)&1)*32+(lane&3)*8+(4*hi+((lane&15)>>2))*64;
  const char*Kbase=shm+LDS_K; bf16x8 kf[8];
  const lds_cptr shm3=(lds_cptr)shm; const lds_cptr kp0=shm3+LDS_K+hi*1024+r32*16; const lds_cptr vp0=shm3+LDS_V+((lane>>4)&1)*32+(lane&3)*8+(4*hi+((lane&15)>>2))*64;
  const int NT=(q0+QB)/KVBLK;
  if(FOX){ float*bl=(float*)(shm+LDS_BIAS); for(int i=tid;i<(q0+QB)/4;i+=NW*64)((f32x4_t*)bl)[i]=((const f32x4_t*)CB)[i]; asm volatile("s_waitcnt vmcnt(0) lgkmcnt(0)":::"memory"); }
  const lds_cptr bp0=(lds_cptr)shm+LDS_BIAS+hi*16;
  DMA_K(0,0);DMA_V(0,0);DMA_K(1,SLOTB);
  bf16x8 qr[4];
  #pragma unroll
  for(int d0=0;d0<4;++d0)qr[d0]=*reinterpret_cast<const bf16x8*>(&Qw[(long)r32*PQ+d0*16+hi*8]);
  float mhat=0.f,l_reg=0.f;f32x16 o[2];o[0]=f32x16{};o[1]=f32x16{};float z0_;asm volatile("v_mov_b32 %0, 0":"=v"(z0_));f32x16 negm;_Pragma("unroll") for(int r=0;r<16;++r)negm[r]=z0_;asm volatile("":"+v"(negm));
  const int qrel=wid*QBLK+r32;
  #define CMASK(P0,P1,t) do{int jb_=(t)-(NT-4); if(jb_>=0)cmask(P0,P1,jb_,qrel,hi);}while(0)
  #define BIASADD(P0,P1,t) do{ if(FOX){ const lds_cptr bq_=bp0+(t)*256; _Pragma("unroll") for(int g_=0;g_<4;++g_){ const f32x4_t b0_=*(const __attribute__((address_space(3))) f32x4_t*)(bq_+g_*32), b1_=*(const __attribute__((address_space(3))) f32x4_t*)(bq_+g_*32+128); \
      _Pragma("unroll") for(int e_=0;e_<4;++e_){ P0[4*g_+e_]+=b0_[e_]; P1[4*g_+e_]+=b1_[e_]; } } } }while(0)
  bool resc=false;
  #define START(P0,P1) do{ const float rm=rowmax(P0,P1); resc=false; \
    { const float dl=rm; mhat=fadd_s(mhat,dl); \
      _Pragma("unroll") for(int r=0;r<16;++r){P0[r]=fsub_s(P0[r],dl);P1[r]=fsub_s(P1[r],dl);} \
      _Pragma("unroll") for(int r=0;r<16;++r)negm[r]=-mhat; asm volatile("":"+v"(negm)); } \
    _Pragma("unroll") for(int r=0;r<16;++r)P0[r]=__builtin_amdgcn_exp2f(P0[r]); }while(0)
  #define RESC() do{ if(resc){ asm volatile("s_waitcnt lgkmcnt(0)":::"memory"); \
      _Pragma("unroll") for(int d_=0;d_<2;++d_) _Pragma("unroll") for(int r=0;r<16;++r)o[d_][r]*=wsf[crow(r,hi)]; } }while(0)
  f32x16 pA0,pA1,pB0,pB1;
  int sl_prev=0,sl_cur=0,sl_next=SLOTB;
  #define ROT() do{sl_prev=sl_cur;sl_cur=sl_next;sl_next=(sl_next==(NSLOT-1)*SLOTB)?0:sl_next+SLOTB;}while(0)
  DMA_K(2,2*SLOTB);
  WAIT_BAR(3);
  qkt(pA0,pA1,Kbase,qr,negm,r32,hi);asm volatile("s_nop 15\n\ts_nop 7":"+v"(pA0),"+v"(pA1));BIASADD(pA0,pA1,0);CMASK(pA0,pA1,0);
  START(pA0,pA1);
  _Pragma("unroll") for(int r=0;r<16;++r)pA1[r]=__builtin_amdgcn_exp2f(pA1[r]);
  WAIT_BAR(0);
  DMA_K(3,0);DMA_V(1,SLOTB);
  ROT();
  kload8(kf,kp0+sl_cur);
  WAIT_BAR(2);
  s16x4 vlo[8],vhi[8]; u32x4 pw0,pw1,pw2,pw3;
  #define PKW(P,B) cvtpk_s(P[B],P[B+1])
  #define PAF(k) __builtin_bit_cast(bf16x8,pw##k)
  #define VFR(i) (bf16x8){vlo[i][0],vlo[i][1],vlo[i][2],vlo[i][3],vhi[i][0],vhi[i][1],vhi[i][2],vhi[i][3]}
  #define PIN(x) asm volatile("":"+v"(x))
  #define MX3(a,b,c) __builtin_fmaxf(__builtin_fmaxf((a),(b)),(c))
  #define GAPA(MF,A0,A1,A2,A3,W0,W1,PW) do{ MF; sacc+=A0; sacc+=A1; sacc+=A2; sacc+=A3; PIN(sacc); W0; W1; PIN(PW); SBAR(); }while(0)
  #define EX(v) __builtin_amdgcn_exp2f(v)
  #define GAPB(MF,X,B) do{ MF; X[B]=EX(X[B]); X[B+1]=EX(X[B+1]); X[B+2]=EX(X[B+2]); X[B+3]=EX(X[B+3]); PIN(X); SBAR(); }while(0)
  #define VRD(i) do{ vlo[i]=vtr(vp_+(((i)>>2)*4096+((i)&3)*1024)); vhi[i]=vtr(vp_+(((i)>>2)*4096+((i)&3)*1024+512)); }while(0)
  #define KRD(G,j) do{ if(G){ kload2(kf,kp0+sl_next,j); SBAR(); } }while(0)
  #define STEP(C0,C1,P0,P1,t,GK,GV,GL) do{ SBAR(); \
    const lds_cptr vp_=vp0+sl_prev; \
    VRD(0); SBAR(); float sacc=(P0[0]+P0[1]); \
    GAPA(C0=__builtin_amdgcn_mfma_f32_32x32x16_bf16(kf[0],qr[0],negm,0,0,0), P0[2],P0[3],P0[4],P0[5],     pw0[0]=PKW(P0,0), pw0[1]=PKW(P0,2), pw0); \
    VRD(4); SBAR(); GAPA(C1=__builtin_amdgcn_mfma_f32_32x32x16_bf16(kf[1],qr[0],negm,0,0,0), P0[6],P0[7],P0[8],P0[9],     pw0[2]=PKW(P0,4), pw0[3]=PKW(P0,6), pw0); \
    VRD(1); SBAR(); GAPA(C0=__builtin_amdgcn_mfma_f32_32x32x16_bf16(kf[2],qr[1],C0,0,0,0),   P0[10],P0[11],P0[12],P0[13], pw1[0]=PKW(P0,8), pw1[1]=PKW(P0,10), pw1); \
    VRD(5); SBAR(); GAPA(C1=__builtin_amdgcn_mfma_f32_32x32x16_bf16(kf[3],qr[1],C1,0,0,0),   P0[14],P0[15],P1[0],P1[1],   pw1[2]=PKW(P0,12),pw1[3]=PKW(P0,14), pw1); \
    VRD(2); SBAR(); GAPA(C0=__builtin_amdgcn_mfma_f32_32x32x16_bf16(kf[4],qr[2],C0,0,0,0),   P1[2],P1[3],P1[4],P1[5],     pw2[0]=PKW(P1,0), pw2[1]=PKW(P1,2), pw2); \
    VRD(6); SBAR(); GAPA(C1=__builtin_amdgcn_mfma_f32_32x32x16_bf16(kf[5],qr[2],C1,0,0,0),   P1[6],P1[7],P1[8],P1[9],     pw2[2]=PKW(P1,4), pw2[3]=PKW(P1,6), pw2); \
    VRD(3); SBAR(); GAPA(C0=__builtin_amdgcn_mfma_f32_32x32x16_bf16(kf[6],qr[3],C0,0,0,0),   P1[10],P1[11],P1[12],P1[13], pw3[0]=PKW(P1,8), pw3[1]=PKW(P1,10), pw3); \
    VRD(7); SBAR(); GAPA(C1=__builtin_amdgcn_mfma_f32_32x32x16_bf16(kf[7],qr[3],C1,0,0,0),   P1[14],P1[15],0.f,0.f,       pw3[2]=PKW(P1,12),pw3[3]=PKW(P1,14), pw3); \
    l_reg+=sacc; \
    if(GK){DMA_K((t)+3,sl_cur);} if(GV){DMA_V((t)+1,sl_next);} \
    BIASADD(C0,C1,t); CMASK(C0,C1,t); \
    { float a=MX3(C0[0],C0[1],C1[0]),b=MX3(C0[2],C0[3],C1[1]); a=MX3(a,C1[2],C1[3]); \
      _Pragma("unroll") for(int r=4;r<16;r+=4){a=MX3(a,C0[r],C0[r+1]);b=MX3(b,C0[r+2],C0[r+3]);a=MX3(a,C1[r],C1[r+1]);b=MX3(b,C1[r+2],C1[r+3]);} \
      float rm=__builtin_fmaxf(a,b); { auto rr=__builtin_amdgcn_permlane32_swap(__float_as_uint(rm),__float_as_uint(rm),false,false); rm=__builtin_fmaxf(__uint_as_float(rr[0]),__uint_as_float(rr[1])); } \
      resc=false; \
      if(__builtin_expect(__any(rm>(float)THRL),0)){ const float dl=__builtin_fmaxf(rm,0.f); mhat+=dl; \
        _Pragma("unroll") for(int r=0;r<16;++r){C0[r]-=dl;C1[r]-=dl;} \
        _Pragma("unroll") for(int r=0;r<16;++r)negm[r]=-mhat; asm volatile("":"+v"(negm)); \
        const float f=__builtin_amdgcn_exp2f(-dl); l_reg*=f; if(hi==0)wsf[r32]=f; resc=true; } } \
    SBAR(); \
    GAPB(o[0]=__builtin_amdgcn_mfma_f32_32x32x16_bf16(PAF(0),VFR(0),o[0],0,0,0), C0,0); \
    GAPB(o[1]=__builtin_amdgcn_mfma_f32_32x32x16_bf16(PAF(0),VFR(4),o[1],0,0,0), C0,4); \
    KRD(GL,0); GAPB(o[0]=__builtin_amdgcn_mfma_f32_32x32x16_bf16(PAF(1),VFR(1),o[0],0,0,0), C0,8); \
    KRD(GL,1); GAPB(o[1]=__builtin_amdgcn_mfma_f32_32x32x16_bf16(PAF(1),VFR(5),o[1],0,0,0), C0,12); \
    KRD(GL,2); GAPB(o[0]=__builtin_amdgcn_mfma_f32_32x32x16_bf16(PAF(2),VFR(2),o[0],0,0,0), C1,0); \
    KRD(GL,3); GAPB(o[1]=__builtin_amdgcn_mfma_f32_32x32x16_bf16(PAF(2),VFR(6),o[1],0,0,0), C1,4); \
    GAPB(o[0]=__builtin_amdgcn_mfma_f32_32x32x16_bf16(PAF(3),VFR(3),o[0],0,0,0), C1,8); \
    GAPB(o[1]=__builtin_amdgcn_mfma_f32_32x32x16_bf16(PAF(3),VFR(7),o[1],0,0,0), C1,12); \
    }while(0)
  int t=1;
  #undef CMASK
  #define CMASK(P0,P1,t) do{}while(0)
  for(;t+5<NT;t+=2){
    STEP(pB0,pB1,pA0,pA1,t,true,true,true);     WAIT_BAR(2); RESC(); ROT();
    STEP(pA0,pA1,pB0,pB1,t+1,true,true,true);   WAIT_BAR(2); RESC(); ROT();
  }
  #undef CMASK
  #define CMASK(P0,P1,t) do{int jb_=(t)-(NT-4); if(jb_>=0)cmask(P0,P1,jb_,qrel,hi);}while(0)
  #define ENDW(tt) do{ if((tt)+3<NT){WAIT_BAR(2);} else if((tt)+2<NT){WAIT_BAR(1);} else {WAIT_BAR(0);} }while(0)
  for(;t+1<NT;t+=2){
    STEP(pB0,pB1,pA0,pA1,t,(t+3<NT),(t+1<NT),(t+1<NT));       ENDW(t);   RESC(); ROT();
    STEP(pA0,pA1,pB0,pB1,t+1,(t+4<NT),(t+2<NT),(t+2<NT));     ENDW(t+1); RESC(); ROT();
  }
  STEP(pB0,pB1,pA0,pA1,NT-1,false,false,false); RESC();
  { float sacc=pB0[0]+pB0[1]; _Pragma("unroll") for(int r=2;r<16;++r)sacc+=pB0[r]; _Pragma("unroll") for(int r=0;r<16;++r)sacc+=pB1[r]; l_reg+=sacc;
    pw0=(u32x4){PKW(pB0,0),PKW(pB0,2),PKW(pB0,4),PKW(pB0,6)};pw1=(u32x4){PKW(pB0,8),PKW(pB0,10),PKW(pB0,12),PKW(pB0,14)};pw2=(u32x4){PKW(pB1,0),PKW(pB1,2),PKW(pB1,4),PKW(pB1,6)};pw3=(u32x4){PKW(pB1,8),PKW(pB1,10),PKW(pB1,12),PKW(pB1,14)};
    SBAR(); pv(o,vb0+sl_cur,PAF(0),PAF(1),PAF(2),PAF(3)); }
  #undef PKW
  #undef PAF
  #undef VFR
  #undef PIN
  #undef MX3
  #undef GAPA
  #undef GAPB
  #undef EX
  #undef VRD
  #undef KRD
  #undef STEP
  #undef ENDW
  {auto rr=__builtin_amdgcn_permlane32_swap(__float_as_uint(l_reg),__float_as_uint(l_reg),false,false);l_reg=__uint_as_float(rr[0])+__uint_as_float(rr[1]);}
  if(hi==0)wsf[32+r32]=l_reg;asm volatile("s_waitcnt lgkmcnt(0)":::"memory");
  float rli[16];
  #pragma unroll
  for(int r=0;r<16;++r)rli[r]=__builtin_amdgcn_rcpf(wsf[32+crow(r,hi)]);
  bf16*Ow=O+(rowbase+q0+wid*QBLK)*PO+ocol;
  { bf16*stg=(bf16*)(shm+LDS_OST)+wid*2048;
    #pragma unroll
    for(int r=0;r<16;++r){const int orow=crow(r,hi);
      #pragma unroll
      for(int d0=0;d0<2;++d0)stg[orow*64+d0*32+r32]=__float2bfloat16(o[d0][r]*rli[r]);}
    asm volatile("s_waitcnt lgkmcnt(0)":::"memory");
    #pragma unroll
    for(int i=0;i<4;++i){const int row=i*8+(lane>>3),ch=lane&7; const u32x4 v=*(const u32x4*)(stg+row*64+ch*8); ATTN_STORE16(Ow+(long)row*PO+ch*8,v);} }
  asm volatile("s_waitcnt lgkmcnt(0)\n\ts_barrier":::"memory");
  #undef DMA_K
  #undef DMA_V
  #undef CMASK
  #undef BIASADD
  #undef START
  #undef RESC
  #undef ROT
}
constexpr int ATTN_LDS_BYTES=LDS_BYTES;
#undef SBAR
#undef WAIT_BAR
}
#define LAS __attribute__((address_space(3)))
#define XB_TMO      128
#define XB_XCNT(j)  (256  + 64 * (j))
#define XB_XSUB(j)  (1280 + 64 * (j))
#define XB_XGEN(j)  (2304 + 64 * (j))
#define XB_TOP      3328
#define XB_TOPGEN   3392
#define XCD_BAR_WORDS 3456
#define XB_SPIN_CAP (1u << 18)

__device__ __forceinline__ unsigned xb_ld(unsigned* p)              { return __hip_atomic_load(p, __ATOMIC_RELAXED, __HIP_MEMORY_SCOPE_AGENT); }
__device__ __forceinline__ unsigned xb_add(unsigned* p, unsigned v) { return __hip_atomic_fetch_add(p, v, __ATOMIC_RELAXED, __HIP_MEMORY_SCOPE_AGENT); }
__device__ __forceinline__ unsigned xb_xcc_id() { return (unsigned)__builtin_amdgcn_s_getreg((3 << 11) | 20) & 0xFu; }
#define XB_SPIN(cond, bar) do { unsigned _sp = 0; while (cond) { __builtin_amdgcn_s_sleep(1); \
    if ((++_sp & 255u) == 0u) { if (xb_ld(&(bar)[XB_TMO])) break; if (_sp > XB_SPIN_CAP) { atomicAdd(&(bar)[XB_TMO], 1u); break; } } } } while (0)

struct XcdBarrier {
    unsigned* bar; unsigned x;
    volatile LAS unsigned* st;
};

__device__ __forceinline__ XcdBarrier xcd_barrier_post(unsigned* bar, volatile LAS unsigned* st) {
    XcdBarrier b; b.bar = bar; b.x = xb_xcc_id(); b.st = st;
    if (threadIdx.x == 0) (void)xb_add(&bar[XB_XCNT(b.x)], 1u);
    return b;
}
__device__ __forceinline__ void xcd_barrier_complete(unsigned* bar, unsigned x, unsigned& nloc, unsigned& nx) {
    const unsigned G = gridDim.x * gridDim.y * gridDim.z;
    unsigned sum, cnt, mine, sp = 0u;
    for (;;) {
        sum = 0u; cnt = 0u; mine = 0u;
#pragma unroll
        for (unsigned j = 0; j < 16; ++j) { const unsigned c = xb_ld(&bar[XB_XCNT(j)]); sum += c; cnt += (c > 0u) ? 1u : 0u; mine = (j == x) ? c : mine; }
        if (sum == G) break;
        __builtin_amdgcn_s_sleep(1);
        if ((++sp & 255u) == 0u) { if (xb_ld(&bar[XB_TMO])) break; if (sp > XB_SPIN_CAP) { atomicAdd(&bar[XB_TMO], 1u); break; } }
    }
    nloc = mine > 0u ? mine : 1u; nx = cnt > 0u ? cnt : 1u;
}

__device__ __forceinline__ void xcd_barrier(const XcdBarrier& b) {
    asm volatile("s_waitcnt vmcnt(0)" ::: "memory");
    __syncthreads();
    if (threadIdx.x == 0) {
        unsigned* bar = b.bar;
        __builtin_amdgcn_s_waitcnt(0);
        unsigned nloc = b.st[0], nx = b.st[1];
        if (nloc == 0u) { xcd_barrier_complete(bar, b.x, nloc, nx); b.st[0] = nloc; b.st[1] = nx; }
        const unsigned old = xb_add(&bar[XB_XSUB(b.x)], 1u);
        const unsigned gen = old / nloc;
        if (old + 1u == (gen + 1u) * nloc) {
            __builtin_amdgcn_fence(__ATOMIC_RELEASE, "agent");
            asm volatile("s_waitcnt vmcnt(0)" ::: "memory");
            const unsigned og = xb_add(&bar[XB_TOP], 1u);
            const unsigned tg = og / nx;
            if (og + 1u == (tg + 1u) * nx) xb_add(&bar[XB_TOPGEN], 1u);
            else XB_SPIN(xb_ld(&bar[XB_TOPGEN]) == tg, bar);
            __builtin_amdgcn_fence(__ATOMIC_ACQUIRE, "agent");
            xb_add(&bar[XB_XGEN(b.x)], 1u);
            asm volatile("s_waitcnt vmcnt(0)" ::: "memory");
        } else {
            XB_SPIN(xb_ld(&bar[XB_XGEN(b.x)]) == gen, bar);
            __builtin_amdgcn_fence(__ATOMIC_ACQUIRE, "agent");
            asm volatile("s_waitcnt vmcnt(0)" ::: "memory");
        }
    }
    __syncthreads();
}


__device__ __forceinline__ void transpose_item(const float* __restrict__ W, int K, int ldw, int ncols, bf16* __restrict__ WT, LAS unsigned char* scr, int item, int lane) {
    const int nblk = ncols / 64, kb = item / nblk, nb = item % nblk, k0 = 64 * kb, n0 = 64 * nb;
    const float* src = W + (size_t)(k0 + (lane >> 4)) * ldw + n0;
#pragma unroll
    for (int j = 0; j < 16; ++j) { const int k = 4 * j + (lane >> 4), cg = ((lane & 15) + (k >> 3)) & 15;
        __builtin_amdgcn_global_load_lds((const unsigned*)(src + (size_t)(4 * j) * ldw + cg * 4), (LAS unsigned*)(scr + j * 1024), 16, 0, 0); }
    asm volatile("s_waitcnt vmcnt(0)" ::: "memory");
    const int k8 = lane & 7; const LAS float* sp = (const LAS float*)scr + (k8 * 8) * 64;
#pragma unroll
    for (int i = 0; i < 8; ++i) { const int nl = (lane >> 3) + 8 * i, c = ((nl >> 2) - k8) & 15; const LAS float* q = sp + c * 4 + (nl & 3);
        u32x4 o; o.x = pk2(q[0 * 64], q[1 * 64]); o.y = pk2(q[2 * 64], q[3 * 64]); o.z = pk2(q[4 * 64], q[5 * 64]); o.w = pk2(q[6 * 64], q[7 * 64]);
        *(u32x4*)(WT + (size_t)(n0 + nl) * K + k0 + 8 * k8) = o; }
    asm volatile("s_waitcnt lgkmcnt(0)" ::: "memory");
}
__device__ __forceinline__ void transpose_item8(const float* __restrict__ W, int K, int ldw, int ncols, unsigned char* __restrict__ WT, float scale, LAS unsigned char* scr, int item, int lane) {
    const int nblk = ncols / 64, kb = item / nblk, nb = item % nblk, k0 = 64 * kb, n0 = 64 * nb;
    const float* src = W + (size_t)(k0 + (lane >> 4)) * ldw + n0;
#pragma unroll
    for (int j = 0; j < 16; ++j) { const int k = 4 * j + (lane >> 4), cg = ((lane & 15) + (k >> 3)) & 15;
        __builtin_amdgcn_global_load_lds((const unsigned*)(src + (size_t)(4 * j) * ldw + cg * 4), (LAS unsigned*)(scr + j * 1024), 16, 0, 0); }
    asm volatile("s_waitcnt vmcnt(0)" ::: "memory");
    const int k8 = lane & 7; const LAS float* sp = (const LAS float*)scr + (k8 * 8) * 64;
#pragma unroll
    for (int i = 0; i < 8; ++i) { const int nl = (lane >> 3) + 8 * i, c = ((nl >> 2) - k8) & 15; const LAS float* q = sp + c * 4 + (nl & 3);
        u32x2 o; o.x = pk4_fp8(q[0 * 64] * scale, q[1 * 64] * scale, q[2 * 64] * scale, q[3 * 64] * scale); o.y = pk4_fp8(q[4 * 64] * scale, q[5 * 64] * scale, q[6 * 64] * scale, q[7 * 64] * scale);
        *(u32x2*)(WT + (size_t)(n0 + nl) * K + k0 + 8 * k8) = o; }
    asm volatile("s_waitcnt lgkmcnt(0)" ::: "memory");
}
__device__ __forceinline__ void ph_prologue(const P& p, LAS unsigned char* lds, int bid, int nb) {
    const int tid = opaque_tid(), lane = tid & 63, wave = __builtin_amdgcn_readfirstlane(tid >> 6);
    const int gw = bid * NWAVE + wave, ngw = nb * NWAVE;
    for (int i = bid * NT + tid; i < NE * D; i += nb * NT) { const int e = i >> 10, k = i & 1023; const float w = p.w_router[(size_t)k * NE + e]; const unsigned h = f2bf(w);
        ((bf16*)(p.ws + WS_WRT))[i] = (bf16)h; ((bf16*)(p.ws + WS_WRT))[NE * D + i] = (bf16)f2bf(w - bf2f(h)); }
    for (int it = gw; it < 64; it += ngw) {
        const int mat = it >> 5, e = it & 31;
        const f32x4* W = (const f32x4*)(mat ? p.w_e2 + (size_t)e * DE * D : p.w_e1 + (size_t)e * D * 2 * DE); const int n4 = mat ? 8 * D / 4 : 8 * 2 * DE / 4;
        float am = 0.f;
        for (int i = lane; i < n4; i += 64) { const f32x4 v = W[i]; am = fmaxf(fmaxf(am, fmaxf(fabsf(v.x), fabsf(v.y))), fmaxf(fabsf(v.z), fabsf(v.w))); }
#pragma unroll
        for (int o = 1; o < 64; o <<= 1) am = fmaxf(am, __shfl_xor(am, o));
        if (lane == 0) { const int ex = (am > 0.f && am < 3.0e38f) ? ilogbf(am) : 0; float* SCL = (float*)(p.ws + WS_SCL) + mat * 64; SCL[e] = ldexpf(1.0f, 5 - ex); SCL[32 + e] = ldexpf(1.0f, ex - 5); }
    }
    {
        LAS unsigned char* scr = lds + wave * 16384;
        constexpr int I_IN = (D / 64) * (NPROJ / 64), I_O = (D / 64) * (D / 64), I_G = I_O, I_P = (PLE / 64) * (D / 64);
        constexpr int NITEMS = I_IN + I_O + I_G + I_P;
        for (int it = gw; it < NITEMS; it += ngw) {
            int r = it;
            if (r < I_IN) { transpose_item(p.w_in, D, INW, NPROJ, (bf16*)(p.ws + WS_WIN_T), scr, r, lane); continue; } r -= I_IN;
            if (r < I_O) { transpose_item(p.w_out, D, D, D, (bf16*)(p.ws + WS_WO_T), scr, r, lane); continue; } r -= I_O;
            if (r < I_G) { transpose_item(p.w_gate, D, D, D, (bf16*)(p.ws + WS_WG_T), scr, r, lane); continue; } r -= I_G;
            transpose_item(p.w_proj, PLE, D, D, (bf16*)(p.ws + WS_WP_T), scr, r, lane);
        }
    }
}
__device__ __forceinline__ void ph_prologue_experts(const P& p, LAS unsigned char* lds, int bid, int nb) {
    const int tid = opaque_tid(), lane = tid & 63, wave = __builtin_amdgcn_readfirstlane(tid >> 6);
    const int gw = bid * NWAVE + wave, ngw = nb * NWAVE;
    LAS unsigned char* scr = lds + wave * 16384;
    const float* SCL = (const float*)(p.ws + WS_SCL);
    constexpr int I_E1 = (D / 64) * (2 * DE / 64), I_E2 = (DE / 64) * (D / 64);
    __syncthreads();
    for (int it = gw; it < NE * (I_E1 + I_E2); it += ngw) {
        const int e = it / (I_E1 + I_E2), r = it - e * (I_E1 + I_E2);
        if (r < I_E1) transpose_item8(p.w_e1 + (size_t)e * D * 2 * DE, D, 2 * DE, 2 * DE, p.ws + WS_W1_T + (size_t)e * 2 * DE * D, SCL[e], scr, r, lane);
        else transpose_item8(p.w_e2 + (size_t)e * DE * D, DE, D, D, p.ws + WS_W2_T + (size_t)e * D * DE, SCL[64 + e], scr, r - I_E1, lane);
    }
}
__device__ __forceinline__ void ph_prologue_rows(const P& p, LAS unsigned char* lds, int bid, int nb) {
    const int tid = opaque_tid(), lane = tid & 63, wave = __builtin_amdgcn_readfirstlane(tid >> 6);
    const int gw = bid * NWAVE + wave, ngw = nb * NWAVE;
    bf16* XN = (bf16*)(p.ws + WS_XN); bf16* PB = (bf16*)(p.ws + WS_PB);
    float* LOGF = (float*)(p.ws + WS_LOGF); float* COS = (float*)(p.ws + WS_COS); float* SIN = (float*)(p.ws + WS_SIN);
    for (int idx = (bid * NT + tid); idx < M * 8; idx += nb * NT) {
        const int m = idx >> 3, i = idx & 7;
        const double invf = exp2(-(double)i * 0.125 * 18.931568569324174);
        const double ang = (double)p.pos[m] * invf;
        const double kq = rint(ang * 0.15915494309189535);
        const float rf = (float)((ang - kq * 6.283185307179586) - kq * 2.4492935982947064e-16);
        COS[idx] = cosf(rf); SIN[idx] = sinf(rf);
    }
    LAS float* wz = (LAS float*)lds;
    __syncthreads();
    for (int i = tid; i < D * 8; i += NT) { const int k = i >> 3, c = i & 7; wz[c * D + k] = p.w_in[(size_t)k * INW + NPROJ + c]; }
    __syncthreads();
    for (int m = gw; m < M; m += ngw) {
        const f32x4* xr = (const f32x4*)(p.x + (size_t)m * D) + lane;
        f32x4 v[4]; float ss = 0.f;
#pragma unroll
        for (int j = 0; j < 4; ++j) { v[j] = xr[64 * j]; ss += (v[j].x * v[j].x + v[j].y * v[j].y) + (v[j].z * v[j].z + v[j].w * v[j].w); }
        { const f32x4 pv = ((const f32x4*)(p.p + (size_t)m * PLE))[lane]; u32x2 o; o.x = pk2(pv.x, pv.y); o.y = pk2(pv.z, pv.w); ((u32x2*)(PB + (size_t)m * PLE))[lane] = o; }
        const float rstd = 1.0f / sqrtf(wave_sum(ss) * (1.f / D) + EPS);
        float fz[8];
#pragma unroll
        for (int i = 0; i < 8; ++i) fz[i] = 0.f;
#pragma unroll
        for (int j = 0; j < 4; ++j) {
            const f32x4 g = ((const f32x4*)p.g_attn)[lane + 64 * j];
            v[j] = v[j] * rstd * g;
#pragma unroll
            for (int i = 0; i < 8; ++i) { const f32x4 w = *(const LAS f32x4*)(wz + i * D + 4 * lane + 256 * j); fz[i] += (v[j].x * w.x + v[j].y * w.y) + (v[j].z * w.z + v[j].w * w.w); }
            u32x2 o; o.x = pk2(v[j].x, v[j].y); o.y = pk2(v[j].z, v[j].w);
            *((u32x2*)(XN + (size_t)m * D) + lane + 64 * j) = o;
        }
#pragma unroll
        for (int i = 0; i < 8; ++i) fz[i] = wave_sum(fz[i]);
        if (lane < 8) {
            float z = 0.f;
#pragma unroll
            for (int i = 0; i < 8; ++i) z = (lane == i) ? fz[i] : z;
            z += p.b_forget[lane];
            LOGF[(size_t)m * 8 + lane] = fminf(z, 0.f) - log1pf(__expf(-fabsf(z)));
        }
    }
    __syncthreads();
}

__device__ __forceinline__ void ph_inproj(const P& p, LAS unsigned char* lds, int bid, int nb) {
    const int tid = opaque_tid(), lane = tid & 63, wave = tid >> 6;
    {
        const int gw = bid * NWAVE + wave;
        if (gw < NB * 8) {
            const int b = gw >> 3, h = gw & 7;
            const float* LOGF = (const float*)(p.ws + WS_LOGF); float* CB = (float*)(p.ws + WS_CUM) + (size_t)gw * SEQ;
            float loc[32]; float s = 0.f;
#pragma unroll
            for (int i = 0; i < 32; ++i) { s += LOGF[(size_t)(b * SEQ + lane * 32 + i) * 8 + h]; loc[i] = s; }
            float inc = s;
#pragma unroll
            for (int o = 1; o < 64; o <<= 1) { const float t = __shfl_up(inc, o); if (lane >= o) inc += t; }
            const float excl = inc - s;
#pragma unroll
            for (int i = 0; i < 32; ++i) CB[lane * 32 + i] = -(excl + loc[i]) * LOG2E;
        }
        asm volatile("s_waitcnt vmcnt(0)" ::: "memory"); __syncthreads();
    }
    {
        pg8::DenseSched S; S.init(p.ws + WS_XN, p.ws + WS_WIN_T, M, NPROJ, D, nb, bid);
        pg8::EpiInproj E{(bf16*)(p.ws + WS_PROJ), (const float*)(p.ws + WS_COS), (const float*)(p.ws + WS_SIN)};
        pg8::gemm_phase<pg8::EpiInproj, pg8::DenseSched, true>(lds, D, S, E);
    }
    {
        pg8::DenseSched S; S.init(p.ws + WS_PB, p.ws + WS_WP_T, M, D, PLE, nb, bid);
        pg8::EpiBf16 E{(bf16*)(p.ws + WS_PP), D};
        pg8::gemm_phase<pg8::EpiBf16, pg8::DenseSched, true>(lds, PLE, S, E);
    }
}

struct AUnit { int b, qb, qcol, kcol, vcol, ocol, cb; };
struct FoxOrder {
    int vcu, nb;
    __device__ __forceinline__ bool next(int i, AUnit& u) const {
        const int fp = vcu + (i >> 1) * nb; if (fp >= 256) return false;
        const int hf = (fp >> 2) & 7, s = fp & 3;
        u.b = fp >> 5; u.qb = (i & 1) ? 7 - s : s; u.qcol = 1536 + hf * 64; u.kcol = 2048 + hf * 64; u.vcol = 2560 + hf * 64; u.ocol = 512 + hf * 64; u.cb = u.b * 8 + hf; return true;
    }
};
struct DiffOrder {
    int vcu, nb;
    __device__ __forceinline__ bool next(int i, AUnit& u) const {
        const int v = vcu + (i >> 2) * nb; if (2 * v >= 512) return false;
        const int dp = 2 * v + ((i >> 1) & 1), pr = (dp >> 2) & 15, s = dp & 3, h = pr >> 2, mm = (pr >> 1) & 1, vh = pr & 1;
        u.b = dp >> 6; u.qb = (i & 1) ? 7 - s : s; u.qcol = h * 128 + mm * 64; u.kcol = 512 + u.qcol; u.vcol = 1024 + h * 128 + vh * 64; u.ocol = mm * 512 + h * 128 + vh * 64; u.cb = 0; return true;
    }
};
__device__ __forceinline__ void ph_attn(const P& p, char* shm, int bid, int nb) {
    typedef attn_body::bf16 abf;
    const int vcu = (nb % 8 == 0) ? (bid % 8) * (nb / 8) + bid / 8 : bid;
    const abf* PROJ = (const abf*)(p.ws + WS_PROJ); const float* CB = (const float*)(p.ws + WS_CUM);
    AUnit u;
    { const FoxOrder S{vcu, nb};
      for (int i = 0; S.next(i, u); ++i) attn_body::attn_unit<8, true>(u.b, u.qb, u.qcol, u.kcol, u.vcol, u.ocol, PROJ, PROJ, PROJ, (abf*)(p.ws + WS_MIXED), CB + (size_t)u.cb * SEQ, shm); }
    { const DiffOrder S{vcu, nb};
      for (int i = 0; S.next(i, u); ++i) attn_body::attn_unit<8, false>(u.b, u.qb, u.qcol, u.kcol, u.vcol, u.ocol, PROJ, PROJ, PROJ, (abf*)(p.ws + WS_OATT), nullptr, shm); }
}

__device__ void ph_combine(const P& p, int bid, int nb) {
    const int tid = opaque_tid(), lane = tid & 63, wave = tid >> 6;
    const int gw = bid * NWAVE + wave, ngw = nb * NWAVE;
    const float lam = __expf(wave_sum(p.lq1[lane] * p.lk1[lane])) - __expf(wave_sum(p.lq2[lane] * p.lk2[lane])) + LAMBDA_INIT;
    const bf16* OATT = (const bf16*)(p.ws + WS_OATT); bf16* MIXED = (bf16*)(p.ws + WS_MIXED);
    const float g0 = p.g_subln[2 * lane], g1 = p.g_subln[2 * lane + 1];
    for (int m = gw; m < M; m += ngw) {
#pragma unroll
        for (int h = 0; h < 4; ++h) {
            const unsigned a = *(const unsigned*)(OATT + (size_t)m * D + h * 128 + 2 * lane), c = *(const unsigned*)(OATT + (size_t)m * D + 512 + h * 128 + 2 * lane);
            const float d0 = bf2f(a & 0xffffu) - lam * bf2f(c & 0xffffu), d1 = bf2f(a >> 16) - lam * bf2f(c >> 16);
            const float rstd = 1.0f / sqrtf(wave_sum(d0 * d0 + d1 * d1) * (1.f / 128.f) + EPS);
            *(unsigned*)(MIXED + (size_t)m * D + h * 128 + 2 * lane) = pk2(d0 * rstd * g0 * (1.f - LAMBDA_INIT), d1 * rstd * g1 * (1.f - LAMBDA_INIT));
        }
    }
}

__device__ __forceinline__ void ph_outproj(const P& p, LAS unsigned char* lds, int bid, int nb) {
    pg8::DenseSched S; S.init(p.ws + WS_MIXED, p.ws + WS_WO_T, M, D, D, nb, bid);
    pg8::EpiResF32 E{p.x, (float*)(p.ws + WS_H1), D, (float*)(p.ws + WS_SS)};
    pg8::gemm_phase<pg8::EpiResF32, pg8::DenseSched, true>(lds, D, S, E);
}

typedef float f32x16 __attribute__((ext_vector_type(16)));
__device__ __forceinline__ void ph_route(const P& p, LAS unsigned char* lds, int bid, int nb) {
    const int tid = opaque_tid(), lane = tid & 63, wave = __builtin_amdgcn_readfirstlane(tid >> 6), r32 = lane & 31, hi = lane >> 5;
    const float* H1 = (const float*)(p.ws + WS_H1); const float* SS = (const float*)(p.ws + WS_SS); unsigned char* XQ = p.ws + WS_XN;
    const bf16* WH = (const bf16*)(p.ws + WS_WRT); const bf16* WL = WH + NE * D;
    float* GATE = (float*)(p.ws + WS_GATE);
    LAS unsigned* lcnt = (LAS unsigned*)(lds + LDS_SEL); LAS unsigned* sel = lcnt + 64;
    if (tid < 32) lcnt[tid] = 0u;
    __syncthreads();
    LAS float* rs = (LAS float*)lds;
    LAS unsigned char* xs = lds + 1024 + wave * 10240;
    LAS float* part = (LAS float*)(lds + 1024 + 8 * 10240);
    LAS float* lgs = part + 8 * 32 * 33;
    constexpr int XP = 144;
    int li = 0;
    for (int it = bid; it < M / 32; it += nb, ++li) {
        const int tok0 = it * 32;
        { const int row = tid >> 4, part_ = tid & 15; float s = SS[(size_t)(tok0 + row) * 16 + part_];
          s += __shfl_xor(s, 1); s += __shfl_xor(s, 2); s += __shfl_xor(s, 4); s += __shfl_xor(s, 8);
          if (part_ == 0) rs[row] = 1.0f / sqrtf(s * (1.f / D) + EPS); }
        __syncthreads();
        f32x16 acc;
#pragma unroll
        for (int r = 0; r < 16; ++r) acc[r] = 0.f;
#pragma unroll
        for (int ch = 0; ch < 2; ++ch) {
            const int k0 = wave * 128 + ch * 64;
            const f32x4 g = *(const f32x4*)(p.g_moe + k0 + (lane & 15) * 4);
#pragma unroll
            for (int i8 = 0; i8 < 8; ++i8) {
                const int row = i8 * 4 + (lane >> 4), kq = (lane & 15) * 4;
                const f32x4 h = *(const f32x4*)(H1 + (size_t)(tok0 + row) * D + k0 + kq);
                const float r_ = rs[row];
                const f32x4 y = h * r_ * g;
                const unsigned h0 = f2bf(y[0]), h1 = f2bf(y[1]), h2 = f2bf(y[2]), h3 = f2bf(y[3]);
                u32x2 wh; wh.x = h0 | (h1 << 16); wh.y = h2 | (h3 << 16);
                u32x2 wl; wl.x = pk2(y[0] - bf2f(h0), y[1] - bf2f(h1)); wl.y = pk2(y[2] - bf2f(h2), y[3] - bf2f(h3));
                *(unsigned*)(XQ + (size_t)(tok0 + row) * D + k0 + kq) = pk4_fp8(y[0], y[1], y[2], y[3]);
                *(LAS u32x2*)(xs + row * XP + kq * 2) = wh; *(LAS u32x2*)(xs + 32 * XP + row * XP + kq * 2) = wl;
            }
            asm volatile("s_waitcnt lgkmcnt(0)" ::: "memory");
#pragma unroll
            for (int ks = 0; ks < 4; ++ks) {
                const bf16x8 xh = *(const LAS bf16x8*)(xs + r32 * XP + ks * 32 + hi * 16), xl = *(const LAS bf16x8*)(xs + 32 * XP + r32 * XP + ks * 32 + hi * 16);
                const bf16x8 wh = *(const bf16x8*)(WH + (size_t)r32 * D + k0 + ks * 16 + hi * 8), wl = *(const bf16x8*)(WL + (size_t)r32 * D + k0 + ks * 16 + hi * 8);
                acc = __builtin_amdgcn_mfma_f32_32x32x16_bf16(wh, xh, acc, 0, 0, 0);
                acc = __builtin_amdgcn_mfma_f32_32x32x16_bf16(wl, xh, acc, 0, 0, 0);
                acc = __builtin_amdgcn_mfma_f32_32x32x16_bf16(wh, xl, acc, 0, 0, 0);
            }
            asm volatile("s_waitcnt lgkmcnt(0)" ::: "memory");
        }
#pragma unroll
        for (int r = 0; r < 16; ++r) part[(wave * 32 + (r & 3) + 8 * (r >> 2) + 4 * hi) * 33 + r32] = acc[r];
        __syncthreads();
#pragma unroll
        for (int q = 0; q < 2; ++q) { const int idx = tid + q * NT, e = idx >> 5, t = idx & 31; float s = p.b_router[e];
#pragma unroll
            for (int w = 0; w < 8; ++w) s += part[(w * 32 + e) * 33 + t];
            lgs[t * 33 + e] = s; }
        __syncthreads();
        if (tid < 32) {
            const int m = tok0 + tid; float lg[32];
#pragma unroll
            for (int e = 0; e < 32; ++e) lg[e] = lgs[tid * 33 + e];
            int idx[4]; float val[4];
#pragma unroll
            for (int k = 0; k < 4; ++k) {
                float best = -INFINITY; int bi = 0;
#pragma unroll
                for (int e = 0; e < 32; ++e) { const bool take = lg[e] > best; best = take ? lg[e] : best; bi = take ? e : bi; }
                idx[k] = bi; val[k] = best;
#pragma unroll
                for (int e = 0; e < 32; ++e) lg[e] = (e == bi) ? -INFINITY : lg[e];
            }
            const float e1 = __expf(val[1] - val[0]), e2 = __expf(val[2] - val[0]), e3 = __expf(val[3] - val[0]);
            const float rsum = 1.f / (1.f + e1 + e2 + e3);
            f32x4 gt; gt[0] = rsum; gt[1] = e1 * rsum; gt[2] = e2 * rsum; gt[3] = e3 * rsum;
            *(f32x4*)(GATE + (size_t)m * 4) = gt;
#pragma unroll
            for (int k = 0; k < 4; ++k) { const unsigned lp = atomicAdd((unsigned*)&lcnt[idx[k]], 1u); sel[li * 128 + tid * 4 + k] = (unsigned)idx[k] | (lp << 8); }
        }
        __syncthreads();
    }
    if (tid < 32) ((unsigned*)(p.ws + WS_BCNT))[bid * 32 + tid] = lcnt[tid];
}
__device__ __forceinline__ void ph_route2(const P& p, LAS unsigned char* lds, int bid, int nb) {
    const int tid = opaque_tid();
    const unsigned* BCNT = (const unsigned*)(p.ws + WS_BCNT); unsigned* CNT = (unsigned*)(p.ws + WS_CTL); int* LIST = (int*)(p.ws + WS_LIST);
    LAS unsigned* lcnt = (LAS unsigned*)(lds + LDS_SEL); LAS unsigned* lbase = lcnt + 32; LAS unsigned* sel = lcnt + 64; LAS unsigned* red = (LAS unsigned*)lds;
    { const int e = tid & 31, part = tid >> 5; unsigned s = 0;
      for (int b = part; b < bid; b += 16) s += BCNT[b * 32 + e];
      red[part * 32 + e] = s; }
    __syncthreads();
    if (tid < 32) { unsigned s = 0;
#pragma unroll
        for (int q = 0; q < 16; ++q) s += red[q * 32 + tid];
        lbase[tid] = s; if (bid == nb - 1) CNT[tid] = s + lcnt[tid]; }
    __syncthreads();
    int li = 0;
    for (int it = bid; it < M / 32; it += nb, ++li)
        if (tid < 128) { const unsigned v = sel[li * 128 + tid], e = v & 255u, lp = v >> 8; LIST[e * M + lbase[e] + lp] = it * 128 + tid; }
}

template <int MODE> __device__ __forceinline__ void moe_setup(const P& p, LAS unsigned char* lds, int nN, int bid, int nb) {
    const int tid = opaque_tid();
    LAS pg8::MoeTab* T = (LAS pg8::MoeTab*)(lds + LDS_TAB); LAS int* rowmap = (LAS int*)(lds + LDS_ROWMAP);
    const unsigned* CNT = (const unsigned*)(p.ws + WS_CTL); const int* LIST = (const int*)(p.ws + WS_LIST);
    if (tid == 0) { int ts = 0, rb = 0;
        for (int e = 0; e < NE; ++e) { const int c = (int)CNT[e], mt = (c + 255) >> 8; T->tstart[e] = ts; T->rbase[e] = rb; T->cnt[e] = c; T->mt[e] = mt; ts += mt * nN; rb += mt * 256; }
        T->tstart[32] = ts; }
    __syncthreads();
    pg8::MoeSched<MODE> S{T, rowmap, nN, nb, bid, 0, nullptr, nullptr, 0};
    pg8::Unit u;
    for (int i = 0; i < 9 && S.next(i, u); ++i)
        if (tid < 256) { const int rr = u.pm * 256 + tid; const int v = rr < T->cnt[u.e] ? LIST[u.e * M + rr] : -1; rowmap[i * 256 + tid] = MODE == 1 ? (v < 0 ? 0 : (v >> 2)) : v; }
    __syncthreads();
}
__device__ __forceinline__ void ph_moe1(const P& p, LAS unsigned char* lds, int bid, int nb) {
    moe_setup<1>(p, lds, 8, bid, nb);
    const LAS pg8::MoeTab* T = (const LAS pg8::MoeTab*)(lds + LDS_TAB); const LAS int* rowmap = (const LAS int*)(lds + LDS_ROWMAP);
    pg8::MoeSched<1> S{T, rowmap, 8, nb, bid, D / 2, (const char*)(p.ws + WS_XN), (const char*)(p.ws + WS_W1_T), (size_t)2 * DE * D};
    pg8::EpiMoe1 E{p.ws + WS_ACT, p.b_e1, T, (const float*)(p.ws + WS_SCL) + 32};
    pg8::gemm_phase<pg8::EpiMoe1, pg8::MoeSched<1>, true, true>(lds, D / 2, S, E);
}
__device__ __forceinline__ void ph_moe2(const P& p, LAS unsigned char* lds, int bid, int nb) {
    moe_setup<2>(p, lds, 4, bid, nb);
    const LAS pg8::MoeTab* T = (const LAS pg8::MoeTab*)(lds + LDS_TAB); const LAS int* rowmap = (const LAS int*)(lds + LDS_ROWMAP);
    pg8::MoeSched<2> S{T, rowmap, 4, nb, bid, DE / 2, (const char*)(p.ws + WS_ACT), (const char*)(p.ws + WS_W2_T), (size_t)D * DE};
    pg8::EpiMoe2 E{(bf16*)(p.ws + WS_Y), p.b_e2, rowmap, (const float*)(p.ws + WS_SCL) + 64 + 32};
    pg8::gemm_phase<pg8::EpiMoe2, pg8::MoeSched<2>, true, true>(lds, DE / 2, S, E);
}

__device__ void ph_combine2(const P& p, int bid, int nb) {
    const int tid = opaque_tid(), lane = tid & 63, wave = tid >> 6;
    const int gw = bid * NWAVE + wave, ngw = nb * NWAVE;
    const float* H1 = (const float*)(p.ws + WS_H1); float* H2 = (float*)(p.ws + WS_H2); bf16* XN = (bf16*)(p.ws + WS_XN);
    const bf16* Y = (const bf16*)(p.ws + WS_Y); const float* GATE = (const float*)(p.ws + WS_GATE);
    for (int m = gw; m < M; m += ngw) {
        const f32x4 gt = *(const f32x4*)(GATE + (size_t)m * 4);
        f32x4 v[4]; float ss = 0.f;
#pragma unroll
        for (int j = 0; j < 4; ++j) {
            v[j] = ((const f32x4*)(H1 + (size_t)m * D))[lane + 64 * j];
#pragma unroll
            for (int k = 0; k < 4; ++k) {
                const u32x2 w = *((const u32x2*)(Y + (size_t)(m * 4 + k) * D) + lane + 64 * j);
                const float g = gt[k];
                v[j].x += g * bf2f(w.x & 0xffffu); v[j].y += g * bf2f(w.x >> 16); v[j].z += g * bf2f(w.y & 0xffffu); v[j].w += g * bf2f(w.y >> 16);
            }
            ((f32x4*)(H2 + (size_t)m * D))[lane + 64 * j] = v[j];
            ss += (v[j].x * v[j].x + v[j].y * v[j].y) + (v[j].z * v[j].z + v[j].w * v[j].w);
        }
        const float rstd = 1.0f / sqrtf(wave_sum(ss) * (1.f / D) + EPS);
#pragma unroll
        for (int j = 0; j < 4; ++j) {
            const f32x4 g = ((const f32x4*)p.g_ple)[lane + 64 * j];
            const f32x4 y = v[j] * rstd * g;
            u32x2 o; o.x = pk2(y.x, y.y); o.y = pk2(y.z, y.w);
            *((u32x2*)(XN + (size_t)m * D) + lane + 64 * j) = o;
        }
    }
}

__device__ __forceinline__ void ph_gate(const P& p, LAS unsigned char* lds, int bid, int nb) {
    pg8::DenseSched S; S.init(p.ws + WS_XN, p.ws + WS_WG_T, M, D, D, nb, bid);
    pg8::EpiGate E{(const float*)(p.ws + WS_H2), (const bf16*)(p.ws + WS_PP), p.out, D};
    pg8::gemm_phase<pg8::EpiGate, pg8::DenseSched, true>(lds, D, S, E);
}

__device__ void ph_final(const P& p, int bid, int nb) {
    const int tid = opaque_tid(), lane = tid & 63, wave = tid >> 6;
    const int gw = bid * NWAVE + wave, ngw = nb * NWAVE;
    for (int m = gw; m < M; m += ngw) {
        f32x4* xr = (f32x4*)(p.out + (size_t)m * D) + lane;
        f32x4 v[4]; float ss = 0.f;
#pragma unroll
        for (int j = 0; j < 4; ++j) { v[j] = xr[64 * j]; ss += (v[j].x * v[j].x + v[j].y * v[j].y) + (v[j].z * v[j].z + v[j].w * v[j].w); }
        const float rstd = 1.0f / sqrtf(wave_sum(ss) * (1.f / D) + EPS);
#pragma unroll
        for (int j = 0; j < 4; ++j) xr[64 * j] = v[j] * rstd * ((const f32x4*)p.g_final)[lane + 64 * j];
    }
}

__global__ void __launch_bounds__(NT, 2) k_mega(P p) {
    extern __shared__ __attribute__((aligned(16))) unsigned char lds_raw[];
    LAS unsigned char* lds = (LAS unsigned char*)lds_raw;
    cg::grid_group grid = cg::this_grid();
    const int bid = blockIdx.x, nb = gridDim.x;
    if (threadIdx.x < 2) ((volatile LAS unsigned*)(lds + LDS_MISC))[threadIdx.x] = 0u;
    __syncthreads();
    XcdBarrier bar = xcd_barrier_post((unsigned*)(p.ws + WS_CTL) + CW_BAR, (volatile LAS unsigned*)(lds + LDS_MISC));
#if defined(__HIP_DEVICE_COMPILE__)
#define PH(call) do { typedef const __attribute__((address_space(4))) P CP; CP* kp_ = (CP*)__builtin_amdgcn_kernarg_segment_ptr(); asm volatile("" : "+s"(kp_)); const P q = *kp_; call; } while (0)
#else
#define PH(call) do { const P q = p; call; } while (0)
#endif
    PH(ph_prologue(q, lds, bid, nb)); PH(ph_prologue_rows(q, lds, bid, nb)); xcd_barrier(bar);
    PH(ph_prologue_experts(q, lds, bid, nb)); grid.sync();
    PH(ph_inproj(q, lds, bid, nb)); xcd_barrier(bar);
    PH(ph_attn(q, (char*)lds_raw, bid, nb)); xcd_barrier(bar);
    PH(ph_combine(q, bid, nb)); xcd_barrier(bar);
    PH(ph_outproj(q, lds, bid, nb)); xcd_barrier(bar);
    PH(ph_route(q, lds, bid, nb)); xcd_barrier(bar);
    PH(ph_route2(q, lds, bid, nb)); xcd_barrier(bar);
    PH(ph_moe1(q, lds, bid, nb)); xcd_barrier(bar);
    PH(ph_moe2(q, lds, bid, nb)); xcd_barrier(bar);
    PH(ph_combine2(q, bid, nb)); xcd_barrier(bar);
    PH(ph_gate(q, lds, bid, nb)); xcd_barrier(bar);
    PH(ph_final(q, bid, nb));
#undef PH
}

extern "C" void kernel_launch(void* const* d_in, const int* in_sizes, int n_in, void* d_out, int out_size, void* d_ws, size_t ws_size, hipStream_t stream) {
    if (n_in != 23 || in_sizes[0] != M * D || out_size != M * D || ws_size < WS_END) {
        fprintf(stderr, "kernel_launch: unexpected shapes (n_in %d in0 %d out %d ws %zu)\n", n_in, n_in > 0 ? in_sizes[0] : -1, out_size, ws_size); return; }
    static int grid_blocks = 0;
    if (!grid_blocks) {
        int dev = 0, cus = 0, per_cu = 0;
        hipGetDevice(&dev);
        hipDeviceGetAttribute(&cus, hipDeviceAttributeMultiprocessorCount, dev);
        hipFuncSetAttribute((const void*)k_mega, hipFuncAttributeMaxDynamicSharedMemorySize, LDS_BYTES);
        hipOccupancyMaxActiveBlocksPerMultiprocessor(&per_cu, k_mega, NT, LDS_BYTES);
        if (per_cu < 1) { fprintf(stderr, "kernel_launch: occupancy query says %d blocks per CU\n", per_cu); per_cu = 1; }
        grid_blocks = cus * per_cu;
    }
    P p{};
    p.x = (const float*)d_in[0]; p.p = (const float*)d_in[1]; p.pos = (const int*)d_in[2]; p.g_attn = (const float*)d_in[3]; p.w_in = (const float*)d_in[4];
    p.lq1 = (const float*)d_in[5]; p.lk1 = (const float*)d_in[6]; p.lq2 = (const float*)d_in[7]; p.lk2 = (const float*)d_in[8]; p.g_subln = (const float*)d_in[9];
    p.b_forget = (const float*)d_in[10]; p.w_out = (const float*)d_in[11]; p.g_moe = (const float*)d_in[12]; p.w_router = (const float*)d_in[13]; p.b_router = (const float*)d_in[14];
    p.w_e1 = (const float*)d_in[15]; p.b_e1 = (const float*)d_in[16]; p.w_e2 = (const float*)d_in[17]; p.b_e2 = (const float*)d_in[18];
    p.g_ple = (const float*)d_in[19]; p.w_gate = (const float*)d_in[20]; p.w_proj = (const float*)d_in[21]; p.g_final = (const float*)d_in[22];
    p.out = (float*)d_out; p.ws = (unsigned char*)d_ws;
    if (hipMemsetAsync((char*)d_ws + WS_CTL, 0, CTL_ZERO_BYTES, stream) != hipSuccess) { fprintf(stderr, "kernel_launch: memset of the control words failed\n"); return; }
    void* args[] = {&p};
    hipError_t e = hipLaunchCooperativeKernel((void*)k_mega, dim3(grid_blocks), dim3(NT), args, LDS_BYTES, stream);
    if (e != hipSuccess) fprintf(stderr, "cooperative launch failed: %s (grid %d)\n", hipGetErrorString(e), grid_blocks);
}
```
